# Optimizing an MI355X kernel written in HIP

```python
import jax, jax.numpy as jnp
from jax import lax
import numpy as np

D_MODEL = 1024
BATCH = 8
SEQ = 8192
DEPTH = 1

HG_HEADS = 4
HG_DK = 128
HG_DV = 128
HG_WIDTH = HG_HEADS * HG_DK
HG_VWIDTH = HG_HEADS * HG_DV
HG_CHUNK = 32
ATT_HEADS = 8
ATT_KV_HEADS = 2
ATT_GROUP = ATT_HEADS // ATT_KV_HEADS
ATT_HD = 64
ATT_WIDTH = ATT_HEADS * ATT_HD
ATT_KV_WIDTH = ATT_KV_HEADS * ATT_HD
WINDOW = 128
D_FF = 2816
CONV_W = 3
EPS = 1e-6

HG_Q0 = 0
HG_F0 = HG_Q0 + HG_WIDTH
HG_I0 = HG_F0 + HG_WIDTH
HG_G0 = HG_I0 + HG_VWIDTH
AT_Q0 = HG_G0 + HG_VWIDTH
AT_K0 = AT_Q0 + ATT_WIDTH
AT_V0 = AT_K0 + ATT_KV_WIDTH
GATE_A0 = AT_V0 + ATT_KV_WIDTH
GATE_B0 = GATE_A0 + D_MODEL
IN_COLS = GATE_B0 + D_MODEL

kernel_name = "hgrn2_swa_sink_gated_hybrid"


def rms_norm(x, g):
    xf = x.astype(jnp.float32)
    y = xf * lax.rsqrt(jnp.mean(xf * xf, axis=-1, keepdims=True) + EPS)
    return y.astype(x.dtype) * g


def alibi_slopes(n_heads):
    return 2.0 ** (-8.0 * jnp.arange(1, n_heads + 1, dtype=jnp.float32) / n_heads)


def hgrn2_chunked(q, k, v, log_f):
    b_, s_, h_, dk = q.shape
    dv = v.shape[-1]
    n = s_ // HG_CHUNK
    q = q.reshape(b_, n, HG_CHUNK, h_, dk)
    k = k.reshape(b_, n, HG_CHUNK, h_, dk)
    v = v.reshape(b_, n, HG_CHUNK, h_, dv)
    cum = jnp.cumsum(log_f.reshape(b_, n, HG_CHUNK, h_, dk), axis=2)
    ref = cum[:, :, HG_CHUNK // 2 - 1:HG_CHUNK // 2]
    scores = jnp.einsum('bnthk,bnshk->bnhts', q * jnp.exp(cum - ref), k * jnp.exp(ref - cum))
    causal = jnp.tril(jnp.ones((HG_CHUNK, HG_CHUNK), dtype=bool))
    scores = jnp.where(causal, scores, 0.0)
    o_intra = jnp.einsum('bnhts,bnshv->bnthv', scores, v)
    cum_end = cum[:, :, -1]
    q_inter = q * jnp.exp(cum)
    k_inter = k * jnp.exp(cum_end[:, :, None] - cum)
    decay = jnp.exp(cum_end)

    def step(state, xs):
        qn, kn, vn, dn = xs
        o = jnp.einsum('bthk,bhkv->bthv', qn, state)
        state = dn[..., None] * state + jnp.einsum('bshk,bshv->bhkv', kn, vn)
        return state, o

    state0 = jnp.zeros((b_, h_, dk, dv), dtype=jnp.float32)
    xs = (jnp.moveaxis(q_inter, 1, 0), jnp.moveaxis(k_inter, 1, 0),
          jnp.moveaxis(v, 1, 0).astype(jnp.float32), jnp.moveaxis(decay, 1, 0))
    _, o_inter = lax.scan(step, state0, xs)
    o = o_intra + jnp.moveaxis(o_inter, 0, 1)
    return o.reshape(b_, s_, h_, dv)


def hgrn2_branch(q_pre, f_pre, i_pre, g_pre, lb, out_g):
    b_, s_, _ = q_pre.shape
    q = jax.nn.silu(q_pre.astype(jnp.float32)) * (HG_DK ** -0.5)
    f = lb + (1.0 - lb) * jax.nn.sigmoid(f_pre.astype(jnp.float32))
    k = 1.0 - f
    log_f = jnp.log(f)
    rs = lambda t, d: t.reshape(b_, s_, HG_HEADS, d)
    o = hgrn2_chunked(rs(q, HG_DK), rs(k, HG_DK), rs(i_pre, HG_DV), rs(log_f, HG_DK))
    o = rms_norm(o, out_g.astype(jnp.float32))
    g = rs(g_pre, HG_DV).astype(jnp.float32)
    o = o * jax.nn.silu(g)
    return o.reshape(b_, s_, HG_VWIDTH).astype(q_pre.dtype)


def swa_sink_attention(q, k, v, q_g, k_g, sinks):
    b_, s_, _ = q.shape
    n = s_ // WINDOW
    q = rms_norm(q.reshape(b_, n, WINDOW, ATT_KV_HEADS, ATT_GROUP, ATT_HD), q_g)
    k = rms_norm(k.reshape(b_, n, WINDOW, ATT_KV_HEADS, ATT_HD), k_g)
    v = v.reshape(b_, n, WINDOW, ATT_KV_HEADS, ATT_HD)
    prev = lambda t: jnp.pad(t, ((0, 0), (1, 0), (0, 0), (0, 0), (0, 0)))[:, :-1]
    k2 = jnp.concatenate([prev(k), k], axis=2)
    v2 = jnp.concatenate([prev(v), v], axis=2)
    scores = jnp.einsum('bnikgd,bnjkd->bkgnij', q, k2).astype(jnp.float32) * (ATT_HD ** -0.5)
    i_idx = jnp.arange(WINDOW)[:, None]
    j_idx = jnp.arange(2 * WINDOW)[None, :]
    delta = i_idx + WINDOW - j_idx
    band = (delta >= 0) & (delta < WINDOW)
    valid = band[None] & ((jnp.arange(n)[:, None, None] > 0) | (j_idx >= WINDOW)[None])
    slopes = alibi_slopes(ATT_HEADS).reshape(ATT_KV_HEADS, ATT_GROUP, 1, 1, 1)
    scores = jnp.where(valid, scores - slopes * delta.astype(jnp.float32), -jnp.inf)
    sink = sinks.astype(jnp.float32).reshape(ATT_KV_HEADS, ATT_GROUP, 1, 1, 1)
    m = jnp.maximum(jnp.max(scores, axis=-1, keepdims=True), sink)
    e = jnp.exp(scores - m)
    probs = e / (jnp.sum(e, axis=-1, keepdims=True) + jnp.exp(sink - m))
    out = jnp.einsum('bkgnij,bnjkd->bnikgd', probs.astype(v.dtype), v2)
    return out.reshape(b_, s_, ATT_WIDTH)


def conv_glu(h, w_up, conv_w, conv_b, w_down):
    u = h @ w_up
    gate, val = u[..., :D_FF], u[..., D_FF:]
    s_ = h.shape[1]
    gp = jnp.pad(gate, ((0, 0), (CONV_W - 1, 0), (0, 0)))
    conv = conv_b + sum(conv_w[tap] * gp[:, tap:tap + s_] for tap in range(CONV_W))
    return (jax.nn.gelu(conv, approximate=False) * val) @ w_down


def setup_inputs(seed: int = 0) -> dict:
    key = jax.random.key(seed)
    ks = jax.random.split(key, 16)
    nrm = lambda k, shape, fan_in: jax.random.normal(k, shape, jnp.float32) * fan_in ** -0.5
    return {
        "x": jax.random.normal(ks[0], (BATCH, SEQ, D_MODEL), jnp.float32),
        "norm1_g": 1.0 + 0.02 * jax.random.normal(ks[1], (DEPTH, D_MODEL), jnp.float32),
        "w_in": nrm(ks[2], (DEPTH, D_MODEL, IN_COLS), D_MODEL),
        "hgrn_lb_logits": 0.1 * jax.random.normal(ks[3], (DEPTH + 1, HG_WIDTH), jnp.float32),
        "hgrn_out_g": 1.0 + 0.02 * jax.random.normal(ks[4], (DEPTH, HG_DV), jnp.float32),
        "q_norm_g": 1.0 + 0.02 * jax.random.normal(ks[5], (DEPTH, ATT_HD), jnp.float32),
        "k_norm_g": 1.0 + 0.02 * jax.random.normal(ks[6], (DEPTH, ATT_HD), jnp.float32),
        "attn_sinks": 0.5 * jax.random.normal(ks[7], (DEPTH, ATT_HEADS), jnp.float32),
        "w_branch_a": nrm(ks[8], (DEPTH, HG_VWIDTH, D_MODEL), HG_VWIDTH),
        "w_branch_b": nrm(ks[9], (DEPTH, ATT_WIDTH, D_MODEL), ATT_WIDTH),
        "w_out": nrm(ks[10], (DEPTH, D_MODEL, D_MODEL), D_MODEL),
        "norm2_g": 1.0 + 0.02 * jax.random.normal(ks[11], (DEPTH, D_MODEL), jnp.float32),
        "w_up": nrm(ks[12], (DEPTH, D_MODEL, 2 * D_FF), D_MODEL),
        "conv_w": nrm(ks[13], (DEPTH, CONV_W, D_FF), CONV_W),
        "conv_b": 0.02 * jax.random.normal(ks[14], (DEPTH, D_FF), jnp.float32),
        "w_down": nrm(ks[15], (DEPTH, D_FF, D_MODEL), D_FF),
    }


def reference(x, norm1_g, w_in, hgrn_lb_logits, hgrn_out_g, q_norm_g, k_norm_g, attn_sinks,
              w_branch_a, w_branch_b, w_out, norm2_g, w_up, conv_w, conv_b, w_down):
    lb_table = jnp.cumsum(jax.nn.softmax(hgrn_lb_logits.astype(jnp.float32), axis=0), axis=0)
    for l in range(DEPTH):
        h = rms_norm(x, norm1_g[l])
        cols = h @ w_in[l]
        o_a = hgrn2_branch(cols[..., HG_Q0:HG_F0], cols[..., HG_F0:HG_I0],
                           cols[..., HG_I0:HG_G0], cols[..., HG_G0:AT_Q0],
                           lb_table[l], hgrn_out_g[l])
        o_b = swa_sink_attention(cols[..., AT_Q0:AT_K0], cols[..., AT_K0:AT_V0],
                                 cols[..., AT_V0:GATE_A0], q_norm_g[l], k_norm_g[l], attn_sinks[l])
        gate_a = jax.nn.sigmoid(cols[..., GATE_A0:GATE_B0])
        gate_b = jax.nn.sigmoid(cols[..., GATE_B0:IN_COLS])
        mixed = gate_a * (o_a @ w_branch_a[l]) + gate_b * (o_b @ w_branch_b[l])
        x = x + mixed @ w_out[l]
        h2 = rms_norm(x, norm2_g[l])
        x = x + conv_glu(h2, w_up[l], conv_w[l], conv_b[l], w_down[l])
    return x
```

```cpp
#include <hip/hip_runtime.h>
#include <cstdio>
#include <cstdint>

#define LAS __attribute__((address_space(3)))
#define DI __device__ __forceinline__
typedef unsigned short bf16_t;
typedef short bf16x8 __attribute__((ext_vector_type(8)));
typedef float f32x4 __attribute__((ext_vector_type(4)));
typedef float f32x2 __attribute__((ext_vector_type(2)));
typedef float f32x16 __attribute__((ext_vector_type(16)));
typedef unsigned u32x4 __attribute__((ext_vector_type(4)));
typedef unsigned u32x2 __attribute__((ext_vector_type(2)));


#ifndef MK_N_LAUNCHES
#define MK_N_LAUNCHES 1
#endif

constexpr int DM = 1024, NB = 8, SEQ = 8192, MTOK = NB * SEQ;
constexpr int INC = 4864, DFF = 2816, HGW = 512, ATW = 512, AKW = 128;
constexpr int HG_Q0 = 0, HG_F0 = 512, HG_I0 = 1024, HG_G0 = 1536, AT_Q0 = 2048, AT_K0 = 2560, AT_V0 = 2688, GATE_A0 = 2816, GATE_B0 = 3840;
constexpr float EPS = 1e-6f;
constexpr float LOG2E = 1.4426950408889634f;
constexpr float QSCALE = 0.125f * LOG2E;
constexpr int P4_TPS = 33;
constexpr int P4_NM = NB * P4_TPS;

constexpr size_t MiB = 1u << 20;
constexpr size_t WS_SMALL = 1 * MiB;
constexpr size_t WS_RSTD1 = WS_SMALL, WS_SUMSQ2 = WS_SMALL + 256 * 1024, WS_LB = WS_SMALL + 512 * 1024;
constexpr size_t WS_WIN = 2 * MiB;
constexpr size_t WS_WA = 12 * MiB;
constexpr size_t WS_WB = 13 * MiB;
constexpr size_t WS_WOUT = 14 * MiB;
constexpr size_t WS_WUP = 16 * MiB;
constexpr size_t WS_WDOWN = 28 * MiB;
constexpr size_t WS_XB = 36 * MiB;
constexpr size_t WS_OA = 937 * MiB, WS_OB = 292 * MiB;
constexpr size_t WS_KA = 164 * MiB;
constexpr size_t WS_QA = 228 * MiB;
constexpr size_t WS_X1B = 356 * MiB;
constexpr size_t WS_EREF = 1001 * MiB;
constexpr size_t WS_KBT = 356 * MiB;
constexpr size_t WS_MIXED = 164 * MiB;
constexpr size_t WS_G = 420 * MiB;
constexpr size_t WS_AQ = 484 * MiB;
constexpr size_t WS_AK = 548 * MiB;
constexpr size_t WS_AV = 564 * MiB;
constexpr size_t WS_GA = 580 * MiB;
constexpr size_t WS_GB = 708 * MiB;
constexpr size_t WS_VT = 836 * MiB;
constexpr size_t WS_DEC = 900 * MiB;
constexpr size_t WS_SLOC = 904 * MiB;
constexpr size_t WS_DSEG = 936 * MiB;
constexpr size_t WS_ACT = 580 * MiB;
constexpr size_t WS_END = 1024 * MiB;
constexpr int NSEG = 16, CPS = 16;

constexpr int LDS_BYTES = 163840;
constexpr int STG_OFF = 131072;
constexpr int NTHREADS = 512;

DI unsigned f2bf(float f) { unsigned u = __builtin_bit_cast(unsigned, f); return (u + 0x7fffu + ((u >> 16) & 1u)) >> 16; }
DI unsigned pk2(float lo, float hi) { return f2bf(lo) | (f2bf(hi) << 16); }
DI float bf2f(unsigned short b) { return __builtin_bit_cast(float, (unsigned)b << 16); }
DI float bflo(unsigned w) { return __builtin_bit_cast(float, w << 16); }
DI float bfhi(unsigned w) { return __builtin_bit_cast(float, w & 0xffff0000u); }
typedef __bf16 bf16x2_t __attribute__((ext_vector_type(2)));
DI unsigned cvt_pk_bf16(float lo, float hi) { f32x2 v = {lo, hi}; bf16x2_t b = __builtin_convertvector(v, bf16x2_t); return __builtin_bit_cast(unsigned, b); }
DI float fexp(float x) { return __builtin_amdgcn_exp2f(x * LOG2E); }
DI float sigmoidf_(float x) { return __builtin_amdgcn_rcpf(1.0f + fexp(-x)); }
DI float siluf_(float x) { return x * sigmoidf_(x); }
DI float sig2(float a) { return __builtin_amdgcn_rcpf(1.0f + __builtin_amdgcn_exp2f(a)); }
constexpr float NLN2 = -0.6931471805599453f;
DI float in_colscale(int n) { const int t = n >> 8; return (t < 4 || t == 6 || t == 7 || t >= 11) ? -LOG2E : 1.0f; }
DI int lane_id() { int l; asm volatile("v_mbcnt_lo_u32_b32 %0, -1, 0\n\tv_mbcnt_hi_u32_b32 %0, -1, %0" : "=v"(l)); return l; }
template <int CTRL> DI float dppf(float x) { return __builtin_bit_cast(float, __builtin_amdgcn_update_dpp(__builtin_bit_cast(int, x), __builtin_bit_cast(int, x), CTRL, 0xf, 0xf, false)); }
DI float xor16_sum(float x) { float a = x, b = x; asm volatile("s_nop 1\n\tv_permlane16_swap_b32 %0, %1" : "+v"(a), "+v"(b)); return a + b; }
DI float xor32_sum(float x) { float a = x, b = x; asm volatile("s_nop 1\n\tv_permlane32_swap_b32 %0, %1" : "+v"(a), "+v"(b)); return a + b; }
DI float xor32_max(float x) { float a = x, b = x; asm volatile("s_nop 1\n\tv_permlane32_swap_b32 %0, %1" : "+v"(a), "+v"(b)); return fmaxf(a, b); }
DI float wave_sum(float v) {
#pragma unroll
    for (int o = 1; o < 64; o <<= 1) v += __shfl_xor(v, o);
    return v;
}
DI u32x4 pack8(const f32x4& a, const f32x4& b) { u32x4 w; w.x = cvt_pk_bf16(a[0], a[1]); w.y = cvt_pk_bf16(a[2], a[3]); w.z = cvt_pk_bf16(b[0], b[1]); w.w = cvt_pk_bf16(b[2], b[3]); return w; }
DI void unpack8(const u32x4& w, f32x4& a, f32x4& b) { a = (f32x4){bflo(w.x), bfhi(w.x), bflo(w.y), bfhi(w.y)}; b = (f32x4){bflo(w.z), bfhi(w.z), bflo(w.w), bfhi(w.w)}; }
DI f32x2 gelu_pk(f32x2 v) {
    const f32x2 av = __builtin_elementwise_abs(v), d = av * 0.2316418882f + 1.0f;
    f32x2 t; t.x = __builtin_amdgcn_rcpf(d.x); t.y = __builtin_amdgcn_rcpf(d.y);
    f32x2 q = t * 0.5307027145f + (-0.7265760135f); q = q * t + 0.7107068705f; q = q * t + (-0.142248368f); q = q * t + 0.127414796f; q = q * t;
    const f32x2 s = (v * v) * (-0.72134752044f);
    f32x2 e; e.x = __builtin_amdgcn_exp2f(s.x); e.y = __builtin_amdgcn_exp2f(s.y);
    const f32x2 m = av * (q * e);
    f32x2 o; o.x = fmaxf(v.x, 0.f) - m.x; o.y = fmaxf(v.y, 0.f) - m.y; return o;
}

namespace pg8 {
constexpr int BM = 256, BK = 64, HALF = 128, HTB = HALF * BK * 2, STAGE_BYTES = 8 * HTB, NXCD = 8, WGM = 8;
__host__ __device__ __forceinline__ int lds_byte(int r, int c) { const int st = (r >> 4) * 2 + (c >> 5), rr = r & 15, cc = c & 31, ob = rr * 64 + cc * 2; return st * 1024 + (ob ^ (((ob >> 9) & 1) << 5)); }
__host__ __device__ __forceinline__ void stage_rc(int b, int& R, int& C) { const int st = b / 1024, sb = b % 1024, swz = sb ^ (((sb >> 9) & 1) << 5); R = (st >> 1) * 16 + swz / 64; C = (st & 1) * 32 + (swz % 64) / 2; }
__host__ __device__ __forceinline__ int perm32(int rho) { const int n = rho >> 4, i = rho & 15; return 8 * (i >> 2) + 4 * n + (i & 3); }

struct Unit { int pm, pn, part; };

struct TileOrder {
    int nM, nN, nwg, G, c;
    DI void init(int nM_, int nN_, int G_, int c_) { nM = nM_; nN = nN_; nwg = nM * nN; G = G_; c = c_; }
    DI bool tile(int i, int& pm, int& pn) const {
        const long L = (long)i * G + c; if (L >= nwg) return false;
        int wgid = (int)L; { const int q = nwg / NXCD, r = nwg % NXCD, xcd = wgid % NXCD, off = wgid / NXCD; wgid = (xcd < r ? xcd * (q + 1) : r * (q + 1) + (xcd - r) * q) + off; }
        const int nig = WGM * nN, gid = wgid / nig, fm = gid * WGM, gsz = (nM - fm) < WGM ? (nM - fm) : WGM;
        pm = fm + ((wgid % nig) % gsz); pn = (wgid % nig) / gsz; return true;
    }
};

template <int RM> DI int arow_of(int R) {
    if (RM == 0) return R;
    if (RM == 1) return 128 * (R >> 6) + 8 * (R & 15) + ((R >> 4) & 3);
    return 126 * (R >> 6) + 8 * (R & 15) + ((R >> 4) & 3);
}
template <int RM> constexpr int ahalf_rows() { return RM == 0 ? 128 : 4; }

template <class Epi, class Sched, int RM>
DI void gemm_phase(LAS unsigned char* lds, const int wid, const int K, const Sched& S, const Epi& E) {
    const int lane = lane_id(), tid = wid * 64 + lane, wr = wid >> 2, wc = wid & 3, fr = lane & 15, fq = lane >> 4;
    const int nt = K / BK;
    unsigned voffA[2], voffB[2];
#pragma unroll
    for (int i = 0; i < 2; ++i) { int R, C; stage_rc(tid * 16 + i * 8192, R, C); const int Rb = Epi::PERM ? ((R & ~31) + perm32(R & 31)) : R;
        voffA[i] = (unsigned)(arow_of<RM>(R) * K + C) * 2u; voffB[i] = (unsigned)(Rb * K + C) * 2u; }
    const size_t kstep = (size_t)(BK * 2);
    const size_t hstepA = (size_t)ahalf_rows<RM>() * K * 2, hstepB = (size_t)HALF * K * 2;
    const unsigned ldsw = (unsigned)wid * 1024u;
    const int aoff = lds_byte(wr * 64 + fr, fq * 8), boff = lds_byte(wc * 32 + fr, fq * 8);
#define PG8_SA(b, h) (((b) * 2 + (h)) * HTB)
#define PG8_SB(b, h) ((4 + (b) * 2 + (h)) * HTB)
#define PG8_STAGE(bufoff, gbase, voff) do { const char* _g = (const char*)(gbase); const unsigned _l0 = (unsigned)(size_t)(lds + (bufoff)) + ldsw; \
        asm volatile("s_mov_b32 m0, %3\n\ts_nop 0\n\tglobal_load_lds_dwordx4 %0, %2\n\ts_mov_b32 m0, %4\n\ts_nop 0\n\tglobal_load_lds_dwordx4 %1, %2" \
                     :: "v"((voff)[0]), "v"((voff)[1]), "s"(_g), "s"(_l0), "s"(_l0 + 8192u) : "memory", "m0"); } while (0)
#define PG8_LDA(dst, b, h) do { _Pragma("unroll") for (int m = 0; m < 4; ++m) _Pragma("unroll") for (int k = 0; k < 2; ++k) dst[m][k] = *(const LAS bf16x8*)(lds + PG8_SA(b, h) + aoff + m * 2048 + k * 1024); } while (0)
#define PG8_LDB(dst, b, h) do { _Pragma("unroll") for (int n = 0; n < 2; ++n) _Pragma("unroll") for (int k = 0; k < 2; ++k) dst[n][k] = *(const LAS bf16x8*)(lds + PG8_SB(b, h) + boff + n * 2048 + k * 1024); } while (0)
#define PG8_MMA(ai, bj, At, Bt) do { __builtin_amdgcn_s_setprio(1); _Pragma("unroll") for (int m = 0; m < 4; ++m) _Pragma("unroll") for (int n = 0; n < 2; ++n) _Pragma("unroll") for (int k = 0; k < 2; ++k) \
        acc[ai][bj][m][n] = __builtin_amdgcn_mfma_f32_16x16x32_bf16(Bt[n][k], At[m][k], acc[ai][bj][m][n], 0, 0, 0); __builtin_amdgcn_s_setprio(0); } while (0)
#define PG8_WAIT_V(n) asm volatile("s_waitcnt vmcnt(" #n ")" ::: "memory")
#define PG8_WAIT_L(n) asm volatile("s_waitcnt lgkmcnt(" #n ")" ::: "memory")
#define PG8_WAIT_VX() do { if constexpr (Epi::SX > 0) asm volatile("s_cmp_lg_u32 %0, 0\n\ts_cbranch_scc1 1f\n\ts_waitcnt vmcnt(8)\n1:\n\ts_waitcnt vmcnt(%1)" :: "s"(sx), "n"(8 + Epi::SX) : "memory", "scc"); else PG8_WAIT_V(8); } while (0)
#define PG8_BAR __builtin_amdgcn_s_barrier()
#define PG8_SCHED __builtin_amdgcn_sched_barrier(0)
    Unit cur, nxt; int ui = 0, sxn = 0;
    if (!S.next(0, cur)) return;
    f32x4 acc[2][2][4][2];
#pragma unroll
    for (int a = 0; a < 2; ++a)
#pragma unroll
        for (int b = 0; b < 2; ++b)
#pragma unroll
            for (int m = 0; m < 4; ++m)
#pragma unroll
                for (int n = 0; n < 2; ++n) acc[a][b][m][n] = (f32x4){0.f, 0.f, 0.f, 0.f};
    bf16x8 At[4][2], B0[2][2], B1[2][2];
    const char* cA = S.abase(cur); const char* cB = S.bbase(cur);
    PG8_STAGE(PG8_SB(0, 0), cB, voffB); PG8_STAGE(PG8_SB(0, 1), cB + hstepB, voffB); PG8_STAGE(PG8_SA(0, 0), cA, voffA); PG8_STAGE(PG8_SA(0, 1), cA + hstepA, voffA);
    if (wr == 1) PG8_BAR;
    PG8_WAIT_V(2); PG8_BAR;
    PG8_STAGE(PG8_SB(1, 0), cB + kstep, voffB); PG8_STAGE(PG8_SA(1, 0), cA + kstep, voffA); PG8_STAGE(PG8_SB(1, 1), cB + hstepB + kstep, voffB);
    PG8_WAIT_V(6); PG8_BAR;
    for (;;) {
        const bool has_next = S.next(ui + 1, nxt);
        const char* nA = has_next ? S.abase(nxt) : cA; const char* nB = has_next ? S.bbase(nxt) : cB;
        for (int t = 0; t < nt; t += 2) {
            const bool last = (t == nt - 2);
            const int sx = t == 0 ? sxn : 0;
            const char* a1 = cA + (size_t)(t + 1) * kstep;
            const char* a2 = last ? nA : cA + (size_t)(t + 2) * kstep; const char* b2 = last ? nB : cB + (size_t)(t + 2) * kstep;
            const char* a3 = a2 + kstep; const char* b3 = b2 + kstep;
            if (last) E.prefetch(lds, cur, wid, lane);
            PG8_LDB(B0, 0, 0); PG8_LDB(B1, 0, 1); PG8_SCHED; PG8_LDA(At, 0, 0); PG8_STAGE(PG8_SA(1, 1), a1 + hstepA, voffA);
            PG8_WAIT_VX(); PG8_WAIT_L(0); PG8_BAR; PG8_MMA(0, 0, At, B0); PG8_MMA(0, 1, At, B1); PG8_BAR; PG8_SCHED;
            PG8_LDA(At, 0, 1); PG8_STAGE(PG8_SB(0, 0), b2, voffB); PG8_STAGE(PG8_SB(0, 1), b2 + hstepB, voffB); PG8_STAGE(PG8_SA(0, 0), a2, voffA);
            PG8_WAIT_VX(); PG8_WAIT_L(0); PG8_BAR; PG8_MMA(1, 0, At, B0); PG8_MMA(1, 1, At, B1); PG8_BAR; PG8_SCHED;
            PG8_LDB(B0, 1, 0); PG8_LDB(B1, 1, 1); PG8_SCHED; PG8_LDA(At, 1, 0); PG8_STAGE(PG8_SA(0, 1), a2 + hstepA, voffA);
            PG8_WAIT_V(8); PG8_WAIT_L(0); PG8_BAR; PG8_MMA(0, 0, At, B0); PG8_MMA(0, 1, At, B1); PG8_BAR; PG8_SCHED;
            PG8_LDA(At, 1, 1); PG8_STAGE(PG8_SB(1, 0), b3, voffB); PG8_STAGE(PG8_SB(1, 1), b3 + hstepB, voffB); PG8_STAGE(PG8_SA(1, 0), a3, voffA);
            PG8_WAIT_V(8); PG8_WAIT_L(0); PG8_BAR; PG8_MMA(1, 0, At, B0); PG8_MMA(1, 1, At, B1); PG8_BAR; PG8_SCHED;
        }
        if (wr == 0) PG8_BAR;
        { const int l2 = lane_id(); E(acc, cur, wr, wc, l2 & 15, l2 >> 4); }
        if (!has_next) break;
        if constexpr (Epi::SX > 0) sxn = E.nstore(cur);
        if (!E.keep(cur)) {
#pragma unroll
            for (int a = 0; a < 2; ++a)
#pragma unroll
                for (int b = 0; b < 2; ++b)
#pragma unroll
                    for (int m = 0; m < 4; ++m)
#pragma unroll
                        for (int n = 0; n < 2; ++n) acc[a][b][m][n] = (f32x4){0.f, 0.f, 0.f, 0.f};
        }
        cur = nxt; cA = nA; cB = nB; ++ui;
        if (wr == 1) PG8_BAR;
    }
    PG8_WAIT_V(0);
    PG8_BAR;
#undef PG8_SA
#undef PG8_SB
#undef PG8_STAGE
#undef PG8_LDA
#undef PG8_LDB
#undef PG8_MMA
#undef PG8_WAIT_V
#undef PG8_WAIT_L
#undef PG8_WAIT_VX
#undef PG8_BAR
#undef PG8_SCHED
}
}
using pg8::Unit;

struct SchedPlain {
    pg8::TileOrder T; const char* A; const char* Bt; size_t atile, btile;
    DI bool next(int i, Unit& u) const { u.part = 0; return T.tile(i, u.pm, u.pn); }
    DI const char* abase(const Unit& u) const { return A + (size_t)u.pm * atile; }
    DI const char* bbase(const Unit& u) const { return Bt + (size_t)u.pn * btile; }
};
struct SchedPair {
    pg8::TileOrder T; const char* A0; const char* A1; const char* B0; const char* B1; size_t atile, btile;
    DI bool next(int i, Unit& u) const { u.part = i & 1; return T.tile(i >> 1, u.pm, u.pn); }
    DI const char* abase(const Unit& u) const { return (u.part ? A1 : A0) + (size_t)u.pm * atile; }
    DI const char* bbase(const Unit& u) const { return (u.part ? B1 : B0) + (size_t)u.pn * btile; }
};
struct SchedUp {
    pg8::TileOrder T; const char* A; const char* Bt; size_t btile;
    DI bool next(int i, Unit& u) const { u.part = 0; return T.tile(i, u.pm, u.pn); }
    DI const char* abase(const Unit& u) const { const int b = u.pm / P4_TPS, j = u.pm % P4_TPS; return A + ((long)b * SEQ + 252 * j - 2) * (long)(DM * 2); }
    DI const char* bbase(const Unit& u) const { return Bt + (size_t)u.pn * btile; }
};

DI size_t gate_block(int pm, int ct, int wr, int wc) { return ((size_t)(((pm * 8 + ct) * 2 + wr) * 4 + wc)) * 4096; }
DI void gate_store(const f32x4 (&acc)[2][2][4][2], unsigned char* ga_blk, unsigned char* gb_blk, unsigned lo16) {
#pragma unroll
    for (int k = 0; k < 4; ++k) {
        u32x4 wa = (u32x4){0u, 0u, 0u, 0u}, wb = wa;
#pragma unroll
        for (int r = 0; r < 2; ++r) { const int ai = k >> 1, m = 2 * (k & 1) + r;
#pragma unroll
            for (int n = 0; n < 2; ++n)
                { unsigned ta[4], tb[4];
#pragma unroll
                    for (int e = 0; e < 4; ++e) { ta[e] = __builtin_bit_cast(unsigned, __builtin_fmaf(sig2(acc[ai][0][m][n][e]), 255.0f, 12582912.0f)); tb[e] = __builtin_bit_cast(unsigned, __builtin_fmaf(sig2(acc[ai][1][m][n][e]), 255.0f, 12582912.0f)); }
                    wa[2 * r + n] = __builtin_amdgcn_perm(__builtin_amdgcn_perm(ta[3], ta[2], 0x0c0c0400u), __builtin_amdgcn_perm(ta[1], ta[0], 0x0c0c0400u), 0x05040100u);
                    wb[2 * r + n] = __builtin_amdgcn_perm(__builtin_amdgcn_perm(tb[3], tb[2], 0x0c0c0400u), __builtin_amdgcn_perm(tb[1], tb[0], 0x0c0c0400u), 0x05040100u); } }
        *(u32x4*)(ga_blk + k * 1024 + lo16) = wa;
        *(u32x4*)(gb_blk + k * 1024 + lo16) = wb; }
}
DI void stg_put8(LAS char* stg, unsigned off, u32x2 w) { *(LAS u32x2*)(stg + off) = w; }
template <int SWZ> DI void stg_copy4k(LAS char* stg, char* g0, char* g1, unsigned lo16) {
    asm volatile("s_waitcnt lgkmcnt(0)" ::: "memory");
    const unsigned l0 = SWZ == 0 ? lo16 : (SWZ == 1 ? lo16 ^ (((lo16 >> 9) & 1u) << 4) : lo16 ^ (((lo16 >> 7) & 3u) << 4));
    constexpr unsigned x1 = SWZ == 0 ? 16u : (SWZ == 1 ? 32u : 0u), x2 = SWZ == 0 ? 32u : (SWZ == 1 ? 64u : 0u);
    const u32x4 a = *(const LAS u32x4*)(stg + l0), b = *(const LAS u32x4*)(stg + 1024 + (l0 ^ x1)), c = *(const LAS u32x4*)(stg + 2048 + (l0 ^ x2)), d = *(const LAS u32x4*)(stg + 3072 + (l0 ^ x1 ^ x2));
    *(u32x4*)(g0 + lo16) = a; *(u32x4*)(g0 + 1024 + lo16) = b; *(u32x4*)(g1 + lo16) = c; *(u32x4*)(g1 + 1024 + lo16) = d;
    asm volatile("s_waitcnt lgkmcnt(0)" ::: "memory");
}
DI void headnorm_store(const f32x4 (&acc)[2][2][4][2], int c4, int q4, int fq, int goff, float osc, LAS char* stg, char* g_c0, unsigned lo16) {
    const LAS float* gw = (const LAS float*)(stg + goff);
    const f32x4 g00 = *(const LAS f32x4*)(gw + 8 * fq), g01 = *(const LAS f32x4*)(gw + 8 * fq + 4), g10 = *(const LAS f32x4*)(gw + 32 + 8 * fq), g11 = *(const LAS f32x4*)(gw + 32 + 8 * fq + 4);
    asm volatile("s_waitcnt lgkmcnt(0)" ::: "memory");
    u32x4 pa[8], pb[8];
#pragma unroll
    for (int ai = 0; ai < 2; ++ai)
#pragma unroll
        for (int m = 0; m < 4; ++m) {
            f32x4 a0 = acc[ai][0][m][0], a1 = acc[ai][0][m][1], b0 = acc[ai][1][m][0], b1 = acc[ai][1][m][1];
            float ss = 0.f;
#pragma unroll
            for (int e = 0; e < 4; ++e) ss += a0[e] * a0[e] + a1[e] * a1[e] + b0[e] * b0[e] + b1[e] * b1[e];
            ss = xor32_sum(xor16_sum(ss));
            const float sc = __builtin_amdgcn_rsqf(ss * (1.0f / 64.0f) + EPS) * osc;
            pa[4 * ai + m] = pack8(a0 * sc * g00, a1 * sc * g01); pb[4 * ai + m] = pack8(b0 * sc * g10, b1 * sc * g11); }
    const unsigned loc = (((unsigned)(fq >> 1) * 512u + (8u * q4 + 32u * (fq & 1)) * 8u) * 2u) ^ ((unsigned)q4 << 4);
#pragma unroll
    for (int r = 0; r < 4; ++r) {
        if (c4 == r) {
#pragma unroll
            for (int j8 = 0; j8 < 8; ++j8) { const unsigned a_ = (loc ^ ((unsigned)(j8 & 3) << 4)) + (unsigned)(j8 >> 2) * 64u; *(LAS u32x4*)(stg + a_) = pa[j8]; *(LAS u32x4*)(stg + a_ + 2048) = pb[j8]; } }
        char* g = g_c0 + (size_t)r * 4096;
        stg_copy4k<2>(stg, g, g + 2048, lo16);
    }
}
template <int MODE> DI void tpiece_store(const f32x4 (&acc)[2][2][4][2], int bj, int c4, int q4, int fq, LAS char* stg, char* g_c0, size_t cstride, unsigned lo16) {
    const unsigned loc = (MODE == 1 ? (((unsigned)q4 * 256u + 8u * fq * 4u) * 2u) ^ ((unsigned)q4 << 4) ^ ((unsigned)(c4 & 1) << 6)
                                    : (((unsigned)(q4 >> 1) * 512u + 8u * fq * 8u + 4u * (q4 & 1)) * 2u) ^ ((unsigned)(q4 >> 1) << 4) ^ ((unsigned)(c4 & 1) << 5)) + (unsigned)(c4 & 1) * 2048u;
    u32x2 w[2][4][2];
#pragma unroll
    for (int n = 0; n < 2; ++n)
#pragma unroll
        for (int e = 0; e < 4; ++e)
#pragma unroll
            for (int ai = 0; ai < 2; ++ai) { float v0 = acc[ai][bj][0][n][e], v1 = acc[ai][bj][1][n][e], v2 = acc[ai][bj][2][n][e], v3 = acc[ai][bj][3][n][e];
                if (MODE == 1) { v0 = v0 * NLN2 * sig2(v0); v1 = v1 * NLN2 * sig2(v1); v2 = v2 * NLN2 * sig2(v2); v3 = v3 * NLN2 * sig2(v3); }
                w[n][e][ai].x = cvt_pk_bf16(v0, v1); w[n][e][ai].y = cvt_pk_bf16(v2, v3); }
#pragma unroll
    for (int r2 = 0; r2 < 2; ++r2) {
        if ((c4 >> 1) == r2) {
#pragma unroll
            for (int n = 0; n < 2; ++n)
#pragma unroll
                for (int e = 0; e < 4; ++e) {
                    const unsigned b_ = MODE == 1 ? (loc ^ ((unsigned)(2 * n + (e >> 1)) << 4)) + (unsigned)(e & 1) * 8u : (loc ^ ((unsigned)e << 4)) + (unsigned)n * 64u;
#pragma unroll
                    for (int ai = 0; ai < 2; ++ai) stg_put8(stg, b_ + (unsigned)ai * (MODE == 1 ? 256u : 512u), w[n][e][ai]); } }
        stg_copy4k<MODE>(stg, g_c0 + (size_t)(2 * r2) * cstride, g_c0 + (size_t)(2 * r2 + 1) * cstride, lo16);
    }
}
DI void qf_store(const f32x4 (&acc)[2][2][4][2], int pm, int head, int wr, int wc, int fr, int fq, const float* lb, bf16_t* KA, bf16_t* QA, float* EREF, bf16_t* KBT, float* DEC, LAS char* stg) {
    const int b = pm >> 5, cw = ((pm & 31) << 3) + 4 * wr, c4 = fr >> 2, q4 = fr & 3;
    const unsigned cbw = (unsigned)((b * 4 + head) * 256 + cw), cb = cbw + c4;
    const int dk0 = 32 * wc + 8 * fq;
    const unsigned lane = (unsigned)(fq * 16 + fr), lo16 = lane * 16u, lh = lane >> 5, ll16 = (lane & 31u) * 16u;
    const f32x4 l0 = *(const LAS f32x4*)(stg + dk0 * 4), l1 = *(const LAS f32x4*)(stg + dk0 * 4 + 16);
    asm volatile("s_waitcnt lgkmcnt(0)" ::: "memory");
    const unsigned hb = (dk0 >> 3) & 1;
    const unsigned kq_l = ((((unsigned)(fq >> 1) * 512u + 4u * hb + 8u * q4 * 8u) * 2u) ^ ((unsigned)q4 << 4) ^ ((unsigned)(c4 & 1) << 6)) + (unsigned)(c4 & 1) * 2048u;
    const unsigned kb_l = ((((unsigned)(q4 >> 1) * 512u + 8u * fq * 8u + 4u * (q4 & 1)) * 2u) ^ ((unsigned)(q4 >> 1) << 4) ^ ((unsigned)(c4 & 1) << 5)) + (unsigned)(c4 & 1) * 2048u;
    u32x2 pkb[8][2];
#pragma unroll
    for (int n = 0; n < 2; ++n) {
        unsigned pqa[8][2], pka[8][2];
#pragma unroll
        for (int ep = 0; ep < 2; ++ep) {
            float qa[2][8], ka[2][8];
#pragma unroll
            for (int eo = 0; eo < 2; ++eo) { const int e = 2 * ep + eo; const float lbv = n ? l1[e] : l0[e];
                float qh[8], kk[8], cum[8];
                float run = 1.f;
#pragma unroll
                for (int j8 = 0; j8 < 8; ++j8) { const int ai = j8 >> 2, m = j8 & 3;
                    const float f = lbv + (1.0f - lbv) * sig2(acc[ai][1][m][n][e]);
                    qh[j8] = acc[ai][0][m][n][e] * (NLN2 * 0.08838834764831845f) * sig2(acc[ai][0][m][n][e]); kk[j8] = 1.0f - f;
                    run *= f; cum[j8] = run; }
                const float t1 = dppf<0x90>(run), t2 = dppf<0x44>(run), t3 = dppf<0x24>(run);
                const float excl = (q4 >= 1 ? t1 : 1.f) * (q4 >= 2 ? t2 : 1.f) * (q4 >= 3 ? t3 : 1.f);
                const float c7 = excl * run;
                const float ref = dppf<0x55>(c7), cend = dppf<0xFF>(c7);
                float kb[8];
                const float rref = __builtin_amdgcn_rcpf(ref), eref = ref, ecr = cend * rref;
#pragma unroll
                for (int j8 = 0; j8 < 8; ++j8) { const float e1 = (excl * cum[j8]) * rref, r1 = __builtin_amdgcn_rcpf(e1);
                    qa[eo][j8] = qh[j8] * e1; ka[eo][j8] = kk[j8] * r1; kb[j8] = ka[eo][j8] * ecr; }
                const unsigned dk = dk0 + 4 * n + e;
                if (q4 == 3) { DEC[cb * 128u + dk] = cend; EREF[cb * 128u + dk] = eref; }
#pragma unroll
                for (int ai = 0; ai < 2; ++ai) { pkb[4 * n + e][ai].x = cvt_pk_bf16(kb[4 * ai], kb[4 * ai + 1]); pkb[4 * n + e][ai].y = cvt_pk_bf16(kb[4 * ai + 2], kb[4 * ai + 3]); }
            }
#pragma unroll
            for (int j8 = 0; j8 < 8; ++j8) { pqa[j8][ep] = cvt_pk_bf16(qa[0][j8], qa[1][j8]); pka[j8][ep] = cvt_pk_bf16(ka[0][j8], ka[1][j8]); }
        }
#pragma unroll
        for (int arr = 0; arr < 2; ++arr) { char* gb = (char*)(arr ? QA : KA);
#pragma unroll
            for (int r2 = 0; r2 < 2; ++r2) {
                if ((c4 >> 1) == r2) {
#pragma unroll
                    for (int j8 = 0; j8 < 8; ++j8) stg_put8(stg, (kq_l ^ ((unsigned)j8 << 4)) + (unsigned)n * 512u, arr ? (u32x2){pqa[j8][0], pqa[j8][1]} : (u32x2){pka[j8][0], pka[j8][1]}); }
                asm volatile("s_waitcnt lgkmcnt(0)" ::: "memory");
#pragma unroll
                for (int k = 0; k < 2; ++k) { const unsigned run = 2u * k + lh, img = run >> 1, frag = run & 1u;
                    const u32x4 v = *(const LAS u32x4*)(stg + img * 2048u + frag * 1024u + (unsigned)n * 512u + (ll16 ^ (((ll16 >> 7) & 3u) << 4) ^ (img << 6)));
                    *(u32x4*)(gb + ((size_t)(cbw + 2 * r2 + img) * 4096 + (2 * wc + frag) * 512) * 2 + n * 512 + ll16) = v; }
                asm volatile("s_waitcnt lgkmcnt(0)" ::: "memory");
            } }
    }
#pragma unroll
    for (int r2 = 0; r2 < 2; ++r2) {
        if ((c4 >> 1) == r2) {
#pragma unroll
            for (int col = 0; col < 8; ++col)
#pragma unroll
                for (int ai = 0; ai < 2; ++ai) stg_put8(stg, (kb_l ^ ((unsigned)(col & 3) << 4)) + (unsigned)(col >> 2) * 64u + (unsigned)ai * 512u, pkb[col][ai]); }
        stg_copy4k<0>(stg, (char*)KBT + ((size_t)(cbw + 2 * r2) * 4096 + 2 * wc * 512) * 2, (char*)KBT + ((size_t)(cbw + 2 * r2 + 1) * 4096 + 2 * wc * 512) * 2, lo16);
    }
}
struct EpiIn {
    static constexpr bool PERM = true;
    DI void prefetch(LAS unsigned char* l, const Unit& u, int wid, int lane) const {
        const float* lbp = (const float*)(ws + WS_LB) + 128 * (u.pn < 4 ? u.pn : 3);
        const float* src = lane < 32 ? lbp + lane * 4 : (lane < 48 ? qg + (lane - 32) * 4 : kg + (lane - 48) * 4);
        __builtin_amdgcn_global_load_lds((const unsigned*)src, (LAS unsigned*)(l + STG_OFF + wid * 4096), 16, 0, 0);
    }
    const float* qg; const float* kg;
    unsigned char* ws; LAS unsigned char* lds; int wave;
    DI bool keep(const Unit&) const { return false; }
    static constexpr int SX = 8;
    DI int nstore(const Unit&) const { return 1; }
    DI void operator()(f32x4 (&acc)[2][2][4][2], const Unit& u, int wr, int wc, int fr, int fq) const {
        bf16_t* KA = (bf16_t*)(ws + WS_KA); bf16_t* QA = (bf16_t*)(ws + WS_QA); float* EREF = (float*)(ws + WS_EREF); bf16_t* KBT = (bf16_t*)(ws + WS_KBT); bf16_t* VT = (bf16_t*)(ws + WS_VT);
        bf16_t* G = (bf16_t*)(ws + WS_G); bf16_t* AQ = (bf16_t*)(ws + WS_AQ); bf16_t* AK = (bf16_t*)(ws + WS_AK); bf16_t* AV = (bf16_t*)(ws + WS_AV); bf16_t* GA = (bf16_t*)(ws + WS_GA); bf16_t* GB = (bf16_t*)(ws + WS_GB);
        float* DEC = (float*)(ws + WS_DEC); const float* lb = (const float*)(ws + WS_LB);
        LAS char* stg = (LAS char*)(lds + STG_OFF + wave * 4096);
        const int rowb = u.pm * 256 + 128 * wr + 8 * fr;
        const int c8 = 32 * wc + 8 * fq;
        const int pn = u.pn;
        const int b = u.pm >> 5, cw = ((u.pm & 31) << 3) + 4 * wr, c4 = fr >> 2, q4 = fr & 3;
        const unsigned lo16 = (unsigned)(fq * 16 + fr) * 16u;
        if (pn < 4) {
            qf_store(acc, u.pm, pn, wr, wc, fr, fq, lb, KA, QA, EREF, KBT, DEC, stg);
        } else if (pn < 6) {
#pragma unroll
            for (int bj = 0; bj < 2; ++bj)
                tpiece_store<0>(acc, bj, c4, q4, fq, stg, (char*)VT + (((size_t)(b * 4 + 2 * (pn - 4) + bj) * 256 + cw) * 4096 + wc * 1024) * 2, (size_t)8192, lo16);
        } else if (pn < 8) {
#pragma unroll
            for (int bj = 0; bj < 2; ++bj)
                tpiece_store<1>(acc, bj, c4, q4, fq, stg, (char*)G + (((size_t)(b * 4 + 2 * (pn - 6) + bj) * 256 + cw) * 4096 + wc * 1024) * 2, (size_t)8192, lo16);
        } else if (pn < 10) {
            headnorm_store(acc, c4, q4, fq, 512, QSCALE, stg, (char*)AQ + ((size_t)(b * 8 + 4 * (pn - 8) + wc) * 256 + cw) * 4096, lo16);
        } else if (pn == 10) {
            if (wc < 2) headnorm_store(acc, c4, q4, fq, 768, 1.0f, stg, (char*)AK + ((size_t)(b * 2 + wc) * 256 + cw) * 4096, lo16);
            else {
#pragma unroll
                for (int bj = 0; bj < 2; ++bj)
                    tpiece_store<0>(acc, bj, c4, q4, fq, stg, (char*)AV + (((size_t)(b * 2 + wc - 2) * 256 + cw) * 2048 + bj * 1024) * 2, (size_t)4096, lo16); }
        } else {
            gate_store(acc, (unsigned char*)GA + gate_block(u.pm, pn - 11, wr, wc), (unsigned char*)GB + gate_block(u.pm, pn - 11, wr, wc), lo16);
        }
    }
};


struct EpiBranch {
    static constexpr bool PERM = true;
    DI void prefetch(LAS unsigned char*, const Unit&, int, int) const {}
    const unsigned char* GA8; const unsigned char* GB8; bf16_t* MIXED;
    DI bool keep(const Unit& u) const { return u.part == 0; }
    static constexpr int SX = 16;
    DI int nstore(const Unit& u) const { return u.part; }
    DI void operator()(f32x4 (&acc)[2][2][4][2], const Unit& u, int wr, int wc, int fr, int fq) const {
        const int rowb = u.pm * 256 + 128 * wr + 8 * fr, colb = u.pn * 256 + 32 * wc + 8 * fq;
        const unsigned lo16 = (unsigned)(fq * 16 + fr) * 16u;
        u32x4 gb[2][4], ga[2][4];
#pragma unroll
        for (int bj = 0; bj < 2; ++bj) { const size_t blk = gate_block(u.pm, 2 * u.pn + bj, wr, wc);
#pragma unroll
            for (int k = 0; k < 4; ++k) { gb[bj][k] = *(const u32x4*)(GB8 + blk + k * 1024 + lo16); if (u.part == 0) ga[bj][k] = *(const u32x4*)(GA8 + blk + k * 1024 + lo16); } }
        __builtin_amdgcn_sched_barrier(0);
#pragma unroll
        for (int ai = 0; ai < 2; ++ai)
#pragma unroll
            for (int m = 0; m < 4; ++m) { const size_t off = (size_t)(rowb + 4 * ai + m) * DM + colb; const int k = 2 * ai + (m >> 1), r = m & 1;
#pragma unroll
                for (int bj = 0; bj < 2; ++bj) {
                    f32x4 g0, g1;
                    const unsigned b0 = gb[bj][k][2 * r], b1 = gb[bj][k][2 * r + 1];
                    g0 = (f32x4){(float)(b0 & 255u), (float)((b0 >> 8) & 255u), (float)((b0 >> 16) & 255u), (float)(b0 >> 24)};
                    g1 = (f32x4){(float)(b1 & 255u), (float)((b1 >> 8) & 255u), (float)((b1 >> 16) & 255u), (float)(b1 >> 24)};
#pragma unroll
                    for (int e = 0; e < 4; ++e) { g0[e] = fmaxf(g0[e], 0.5f); g1[e] = fmaxf(g1[e], 0.5f); }
                    if (u.part == 0) {
                        const unsigned a0 = ga[bj][k][2 * r], a1 = ga[bj][k][2 * r + 1];
                        const f32x4 h0 = (f32x4){(float)(a0 & 255u), (float)((a0 >> 8) & 255u), (float)((a0 >> 16) & 255u), (float)(a0 >> 24)};
                        const f32x4 h1 = (f32x4){(float)(a1 & 255u), (float)((a1 >> 8) & 255u), (float)((a1 >> 16) & 255u), (float)(a1 >> 24)};
#pragma unroll
                        for (int e = 0; e < 4; ++e) { acc[ai][bj][m][0][e] *= h0[e] * __builtin_amdgcn_rcpf(g0[e]); acc[ai][bj][m][1][e] *= h1[e] * __builtin_amdgcn_rcpf(g1[e]); }
                    } else *(u32x4*)(MIXED + off + 128 * bj) = pack8(acc[ai][bj][m][0] * g0 * (1.0f / 255.0f), acc[ai][bj][m][1] * g1 * (1.0f / 255.0f));
                } }
    }
};

struct EpiOut {
    static constexpr bool PERM = true;
    DI void prefetch(LAS unsigned char*, const Unit&, int, int) const {}
    const bf16_t* XN; const float* rms; bf16_t* X1B; float* sumsq;
    DI bool keep(const Unit&) const { return false; }
    static constexpr int SX = 0;
    DI int nstore(const Unit&) const { return 1; }
    DI void operator()(f32x4 (&acc)[2][2][4][2], const Unit& u, int wr, int wc, int fr, int fq) const {
        const int rowb = u.pm * 256 + 64 * wr + fr, colb = u.pn * 256 + 32 * wc + 8 * fq;
        u32x4 xr[2][4][2]; float rr[2][4];
#pragma unroll
        for (int ai = 0; ai < 2; ++ai)
#pragma unroll
            for (int m = 0; m < 4; ++m) { const int row = rowb + 128 * ai + 16 * m; rr[ai][m] = rms[row];
#pragma unroll
                for (int bj = 0; bj < 2; ++bj) xr[ai][m][bj] = *(const u32x4*)(XN + (size_t)row * DM + colb + 128 * bj); }
        __builtin_amdgcn_sched_barrier(0);
#pragma unroll
        for (int ai = 0; ai < 2; ++ai)
#pragma unroll
            for (int m = 0; m < 4; ++m) { const int row = rowb + 128 * ai + 16 * m; const size_t off = (size_t)row * DM + colb; float ss = 0.f;
#pragma unroll
                for (int bj = 0; bj < 2; ++bj) {
                    f32x4 x0, x1; unpack8(xr[ai][m][bj], x0, x1);
                    const f32x4 a = acc[ai][bj][m][0] + x0 * rr[ai][m], b = acc[ai][bj][m][1] + x1 * rr[ai][m];
                    *(u32x4*)(X1B + off + 128 * bj) = pack8(a, b);
#pragma unroll
                    for (int e = 0; e < 4; ++e) ss += a[e] * a[e] + b[e] * b[e]; }
                ss = xor32_sum(xor16_sum(ss));
                if (fq == 0) atomicAdd(sumsq + row, ss); }
    }
};

struct EpiUp {
    static constexpr bool PERM = true;
    const float* sumsq; const float* cw; const float* cb; bf16_t* ACT; LAS unsigned char* lds;
    DI bool keep(const Unit&) const { return false; }
    static constexpr int SX = 8;
    DI int nstore(const Unit&) const { return 1; }
    DI void prefetch(LAS unsigned char* l, const Unit& u, int wid, int lane) const {
        LAS unsigned char* st = l + STG_OFF;
        if (wid == 0) { const int b = u.pm / P4_TPS, j = u.pm % P4_TPS;
#pragma unroll
            for (int q = 0; q < 4; ++q) { int tau = 252 * j - 2 + q * 64 + lane; tau = tau < 0 ? 0 : (tau > SEQ - 1 ? SEQ - 1 : tau);
                __builtin_amdgcn_global_load_lds((const unsigned*)(sumsq + (size_t)b * SEQ + tau), (LAS unsigned*)(st + q * 256), 4, 0, 0); }
        } else if (wid == 1) {
            __builtin_amdgcn_global_load_lds((const unsigned*)(cw + (size_t)(lane >> 5) * DFF + 128 * u.pn + (lane & 31) * 4), (LAS unsigned*)(st + 1024), 16, 0, 0);
        } else if (wid == 2) {
            __builtin_amdgcn_global_load_lds((const unsigned*)((lane < 32 ? cw + 2 * DFF : cb) + 128 * u.pn + (lane & 31) * 4), (LAS unsigned*)(st + 2048), 16, 0, 0);
        }
    }
    DI void operator()(f32x4 (&acc)[2][2][4][2], const Unit& u, int wr, int wc, int fr, int fq) const {
        const int b = u.pm / P4_TPS, j = u.pm % P4_TPS;
        const int tau0 = 252 * j + 126 * wr - 2 + 8 * fr;
        const int col = 128 * u.pn + 32 * wc + 8 * fq;
        const LAS unsigned char* st = lds + STG_OFF;
        const unsigned dumpoff = (unsigned)(352u * 1024u * 1024u) + (unsigned)(fq * 16 + fr) * 16u;
        float rs[8];
#pragma unroll
        for (int k = 0; k < 8; ++k) { const int tau = tau0 + k; const bool ok = tau >= 0 && tau < SEQ; const float s = *(const LAS float*)(st + (126 * wr + 8 * fr + k) * 4);
            rs[k] = ok ? __builtin_amdgcn_rsqf(s * (1.0f / DM) + EPS) : 0.f; }
        f32x4 w0[2], w1[2], w2[2], bb[2];
#pragma unroll
        for (int n = 0; n < 2; ++n) { const int lc = (32 * wc + 8 * fq + 4 * n) * 4; w0[n] = *(const LAS f32x4*)(st + 1024 + lc); w1[n] = *(const LAS f32x4*)(st + 1536 + lc); w2[n] = *(const LAS f32x4*)(st + 2048 + lc); bb[n] = *(const LAS f32x4*)(st + 2560 + lc); }
        f32x4 g[8][2];
#pragma unroll
        for (int ai = 0; ai < 2; ++ai)
#pragma unroll
            for (int m = 0; m < 4; ++m)
#pragma unroll
                for (int n = 0; n < 2; ++n) { const int k = 4 * ai + m; f32x4 v = acc[ai][0][m][n] * rs[k]; if (rs[k] == 0.f) v = (f32x4){0.f, 0.f, 0.f, 0.f}; g[k][n] = v; }
        f32x4 gm1[2], gm2[2];
#pragma unroll
        for (int n = 0; n < 2; ++n)
#pragma unroll
            for (int e = 0; e < 4; ++e) { gm1[n][e] = dppf<0x111>(g[7][n][e]); gm2[n][e] = dppf<0x111>(g[6][n][e]); }
#pragma unroll
        for (int k = 0; k < 8; ++k) {
            const int tau = tau0 + k; const int loc = 8 * fr + k;
            const int ai = k >> 2, m = k & 3;
            u32x4 w;
            f32x4 o[2];
#pragma unroll
            for (int n = 0; n < 2; ++n) {
                const f32x4 p1 = (k >= 1) ? g[k >= 1 ? k - 1 : 0][n] : gm1[n];
                const f32x4 p2 = (k >= 2) ? g[k >= 2 ? k - 2 : 0][n] : (k == 1 ? gm1[n] : gm2[n]);
                const f32x4 cv = bb[n] + w0[n] * p2 + w1[n] * p1 + w2[n] * g[k][n];
                const f32x4 vv = acc[ai][1][m][n] * rs[k];
                const f32x2 ga = gelu_pk((f32x2){cv[0], cv[1]}), gbv = gelu_pk((f32x2){cv[2], cv[3]});
                o[n] = (f32x4){ga.x * vv[0], ga.y * vv[1], gbv.x * vv[2], gbv.y * vv[3]};
            }
            w = pack8(o[0], o[1]);
            const bool ok = loc >= 2 && tau >= 0 && tau < SEQ;
            const unsigned off = ok ? ((unsigned)(b * SEQ + tau) * (unsigned)DFF + (unsigned)col) * 2u : dumpoff;
            *(u32x4*)((char*)ACT + off) = w;
        }
    }
};

struct EpiDown {
    static constexpr bool PERM = true;
    DI void prefetch(LAS unsigned char*, const Unit&, int, int) const {}
    const bf16_t* X1B; float* out;
    DI bool keep(const Unit&) const { return false; }
    static constexpr int SX = 32;
    DI int nstore(const Unit&) const { return 1; }
    DI void operator()(f32x4 (&acc)[2][2][4][2], const Unit& u, int wr, int wc, int fr, int fq) const {
        const int rowb = u.pm * 256 + 64 * wr + fr, colb = u.pn * 256 + 32 * wc + 8 * fq;
        u32x4 rsd[2][4][2];
#pragma unroll
        for (int ai = 0; ai < 2; ++ai)
#pragma unroll
            for (int m = 0; m < 4; ++m)
#pragma unroll
                for (int bj = 0; bj < 2; ++bj) rsd[ai][m][bj] = *(const u32x4*)(X1B + (size_t)(rowb + 128 * ai + 16 * m) * DM + colb + 128 * bj);
        __builtin_amdgcn_sched_barrier(0);
#pragma unroll
        for (int ai = 0; ai < 2; ++ai)
#pragma unroll
            for (int m = 0; m < 4; ++m) { const size_t off = (size_t)(rowb + 128 * ai + 16 * m) * DM + colb;
#pragma unroll
                for (int bj = 0; bj < 2; ++bj) {
                    f32x4 r0, r1; unpack8(rsd[ai][m][bj], r0, r1);
                    *(f32x4*)(out + off + 128 * bj) = acc[ai][bj][m][0] + r0; *(f32x4*)(out + off + 128 * bj + 4) = acc[ai][bj][m][1] + r1; } }
    }
};

DI int colmap_in(int n) {
    const int t = n >> 8, j = n & 255;
    if (t < 4) return j < 128 ? HG_Q0 + 128 * t + j : HG_F0 + 128 * t + (j - 128);
    if (t < 8) return HG_I0 + 256 * (t - 4) + j;
    const int bj = j >> 7, wc = (j >> 5) & 3, e = j & 31;
    if (t < 10) return AT_Q0 + 64 * (4 * (t - 8) + wc) + 32 * bj + e;
    if (t == 10) return wc < 2 ? AT_K0 + 64 * wc + 32 * bj + e : AT_V0 + 64 * (wc - 2) + 32 * bj + e;
    return j < 128 ? GATE_A0 + 128 * (t - 11) + j : GATE_B0 + 128 * (t - 11) + (j - 128);
}
DI int colmap_up(int n) { const int t = n >> 8, j = n & 255; return j < 128 ? 128 * t + j : DFF + 128 * t + (j - 128); }
DI void transpose_item(const float* W, int Kd, int Nsrc, int n0s, bf16_t* WT, int n0d, int k0, const float* gk, LAS float* scr, int lane, float cs = 1.0f) {
#pragma unroll 8
    for (int i = 0; i < 32; ++i) { const int kk = 2 * i + (lane >> 5); float v = W[(size_t)(k0 + kk) * Nsrc + n0s + (lane & 31)]; if (gk) v *= gk[k0 + kk] * cs; scr[kk * 33 + (lane & 31)] = v; }
    asm volatile("s_waitcnt lgkmcnt(0)" ::: "memory");
    const int c = lane & 7;
#pragma unroll
    for (int j = 0; j < 4; ++j) { const int n = (lane >> 3) + 8 * j; const LAS float* s = scr + (8 * c) * 33 + n;
        u32x4 o; o.x = pk2(s[0 * 33], s[1 * 33]); o.y = pk2(s[2 * 33], s[3 * 33]); o.z = pk2(s[4 * 33], s[5 * 33]); o.w = pk2(s[6 * 33], s[7 * 33]);
        *(u32x4*)(WT + (size_t)(n0d + n) * Kd + k0 + 8 * c) = o; }
    asm volatile("s_waitcnt lgkmcnt(0)" ::: "memory");
}


DI f32x16 mfma32(bf16x8 a, bf16x8 b, f32x16 c) { return __builtin_amdgcn_mfma_f32_32x32x16_bf16(a, b, c, 0, 0, 0); }
DI bf16x8 ldfrag(const bf16_t* ubase, int fidx, unsigned lo16) { return *(const bf16x8*)((const char*)(ubase + fidx * 512) + lo16); }
DI bf16x8 packstep(const f32x16& x, int s) { u32x4 p; p.x = cvt_pk_bf16(x[8 * s], x[8 * s + 1]); p.y = cvt_pk_bf16(x[8 * s + 2], x[8 * s + 3]); p.z = cvt_pk_bf16(x[8 * s + 4], x[8 * s + 5]); p.w = cvt_pk_bf16(x[8 * s + 6], x[8 * s + 7]); return __builtin_bit_cast(bf16x8, p); }
DI int crow(int i, int h) { return (i & 3) + 8 * (i >> 2) + 4 * h; }
#define SB0() __builtin_amdgcn_sched_barrier(0)
DI void stage_vec(LAS float* dst, const float* SRC, int gi, int vs, int lane) {
    const size_t cb0 = (size_t)(gi >> 4) * 256 + (gi & 15) * CPS;
#pragma unroll
    for (int k = 0; k < 4; ++k) { const int c = 4 * vs + k; *(LAS f32x2*)(dst + c * 128 + 2 * lane) = *(const f32x2*)((const char*)(SRC + (cb0 + c) * 128) + (unsigned)lane * 8u); }
}
constexpr int PA_RING = 32768, PA_STAGE = 32768;
DI void scan_pass_a(int gi, int vs, int lane, LAS unsigned char* lds, LAS float* decl, const bf16_t* KBT, const bf16_t* VT, const float* DEC, float* SLOC, float* DSEG) {
    const int h = lane >> 5, bh = gi >> 4, g = gi & 15, grp = (int)((decl - (LAS float*)(lds + 4096)) >> 11);
    const unsigned lo16 = (unsigned)lane * 16u;
    f32x16 S[4];
#pragma unroll
    for (int kt = 0; kt < 4; ++kt)
#pragma unroll
        for (int i = 0; i < 16; ++i) S[kt][i] = 0.f;
    const size_t cb0 = (size_t)bh * 256 + g * CPS;
    LAS unsigned char* ring = lds + PA_RING + grp * 16384;
#define PA_ISSUE(c_) do { const int cc_ = (c_) < CPS ? (c_) : CPS - 1; LAS unsigned char* st_ = ring + ((c_) & 3) * PA_STAGE; \
        const char* kb_ = (const char*)(KBT + (cb0 + cc_) * 4096 + (2 * vs) * 512); const char* vb_ = (const char*)(VT + (cb0 + cc_) * 4096 + (2 * vs) * 512); \
        __builtin_amdgcn_global_load_lds((const unsigned*)(kb_ + lo16), (LAS unsigned*)(st_ + (2 * vs) * 1024), 16, 0, 0); \
        __builtin_amdgcn_global_load_lds((const unsigned*)(kb_ + 1024 + lo16), (LAS unsigned*)(st_ + (2 * vs + 1) * 1024), 16, 0, 0); \
        __builtin_amdgcn_global_load_lds((const unsigned*)(vb_ + lo16), (LAS unsigned*)(st_ + 8192 + (2 * vs) * 1024), 16, 0, 0); \
        __builtin_amdgcn_global_load_lds((const unsigned*)(vb_ + 1024 + lo16), (LAS unsigned*)(st_ + 8192 + (2 * vs + 1) * 1024), 16, 0, 0); } while (0)
    PA_ISSUE(0); PA_ISSUE(1); PA_ISSUE(2);
    for (int c = 0; c < CPS; ++c) {
        asm volatile("s_waitcnt vmcnt(8)" ::: "memory");
        __builtin_amdgcn_s_barrier();
        asm volatile("" ::: "memory");
        PA_ISSUE(c + 3);
        const LAS unsigned char* st = ring + (c & 3) * PA_STAGE;
        bf16x8 kf[8], vf[2];
#pragma unroll
        for (int f = 0; f < 8; ++f) kf[f] = *(const LAS bf16x8*)(st + f * 1024 + lo16);
        vf[0] = *(const LAS bf16x8*)(st + 8192 + (2 * vs) * 1024 + lo16); vf[1] = *(const LAS bf16x8*)(st + 8192 + (2 * vs + 1) * 1024 + lo16);
#pragma unroll
        for (int kt = 0; kt < 4; ++kt) {
            f32x4 d[4];
#pragma unroll
            for (int i4 = 0; i4 < 4; ++i4) d[i4] = *(const LAS f32x4*)(decl + c * 128 + 32 * kt + 8 * i4 + 4 * h);
#pragma unroll
            for (int i4 = 0; i4 < 4; ++i4)
#pragma unroll
                for (int e = 0; e < 4; ++e) S[kt][4 * i4 + e] *= d[i4][e];
            S[kt] = mfma32(kf[kt * 2], vf[0], S[kt]);
            S[kt] = mfma32(kf[kt * 2 + 1], vf[1], S[kt]); }
    }
    asm volatile("s_waitcnt vmcnt(0)" ::: "memory");
#undef PA_ISSUE
    float* sl = SLOC + (size_t)(gi * 4 + vs) * 4096;
#pragma unroll
    for (int kt = 0; kt < 4; ++kt)
#pragma unroll
        for (int i4 = 0; i4 < 4; ++i4) *(f32x4*)((char*)(sl + (kt * 4 + i4) * 256) + lo16) = (f32x4){S[kt][4 * i4], S[kt][4 * i4 + 1], S[kt][4 * i4 + 2], S[kt][4 * i4 + 3]};
    if (vs == 0) {
        f32x2 p = (f32x2){1.f, 1.f};
#pragma unroll 4
        for (int c = 0; c < CPS; ++c) p = p * *(const f32x2*)((const char*)(DEC + (cb0 + c) * 128) + (lo16 >> 1));
        *(f32x2*)((char*)(DSEG + (size_t)gi * 128) + (lo16 >> 1)) = p; }
}
DI void scan_pass_b(int gi, int vs, int wave, int lane, LAS float* xl, LAS float* decl, const bf16_t* KA, const bf16_t* QA, const bf16_t* KBT, const bf16_t* VT, const float* DEC,
                    const float* SLOC, const float* DSEG, const bf16_t* GF, const float* og, bf16_t* OA) {
    const int r = lane & 31, h = lane >> 5, bh = gi >> 4, g = gi & 15, b = bh >> 2, hh = bh & 3, grp = wave >> 2;
    const unsigned lo16 = (unsigned)lane * 16u, ho16 = (unsigned)h * 16u;
    f32x16 S[4];
#pragma unroll
    for (int kt = 0; kt < 4; ++kt)
#pragma unroll
        for (int i = 0; i < 16; ++i) S[kt][i] = 0.f;
    if (g > 0) {
        f32x4 P[4][4];
#pragma unroll
        for (int kt = 0; kt < 4; ++kt)
#pragma unroll
            for (int i4 = 0; i4 < 4; ++i4) P[kt][i4] = (f32x4){1.f, 1.f, 1.f, 1.f};
        for (int j = g - 1; j >= 0; --j) {
            const float* sl = SLOC + (size_t)((gi - g + j) * 4 + vs) * 4096; const float* ds = DSEG + (size_t)(gi - g + j) * 128;
            float pmx = 0.f;
#pragma unroll
            for (int kt = 0; kt < 4; ++kt) {
#pragma unroll
                for (int i4 = 0; i4 < 4; ++i4) { const f32x4 x = *(const f32x4*)((const char*)(sl + (kt * 4 + i4) * 256) + lo16); const f32x4 d = *(const f32x4*)((const char*)(ds + 32 * kt + 8 * i4) + ho16);
#pragma unroll
                    for (int e = 0; e < 4; ++e) { S[kt][4 * i4 + e] += P[kt][i4][e] * x[e]; P[kt][i4][e] *= d[e]; pmx = fmaxf(pmx, P[kt][i4][e]); } }
                SB0(); }
            if (__all(pmx == 0.f)) break;
        }
    }
    const float ogv = og[vs * 32 + r];
    const size_t cb0 = (size_t)bh * 256 + g * CPS;
    bf16x8 ka[8], qa[8], kb[8], v0, v1; u32x2 gq[4];
#pragma unroll
    for (int ks = 0; ks < 8; ++ks) { ka[ks] = ldfrag(KA + cb0 * 4096, ks, lo16); qa[ks] = ldfrag(QA + cb0 * 4096, ks, lo16); kb[ks] = ldfrag(KBT + cb0 * 4096, ks, lo16); }
    v0 = ldfrag(VT + cb0 * 4096, vs * 2, lo16); v1 = ldfrag(VT + cb0 * 4096, vs * 2 + 1, lo16);
#pragma unroll
    for (int i4 = 0; i4 < 4; ++i4) gq[i4] = *(const u32x2*)((const char*)(GF + cb0 * 4096 + vs * 1024 + i4 * 256) + (lo16 >> 1));
    for (int c = 0; c < CPS; ++c) {
        const size_t cn = cb0 + (c + 1 < CPS ? c + 1 : c);
        SB0();
        f32x16 X;
#pragma unroll
        for (int i = 0; i < 16; ++i) X[i] = 0.f;
#pragma unroll
        for (int ks = 0; ks < 8; ++ks) X = mfma32(ka[ks], qa[ks], X);
#pragma unroll
        for (int i = 0; i < 16; ++i) if (crow(i, h) > r) X[i] = 0.f;
        const bf16x8 px0 = packstep(X, 0), px1 = packstep(X, 1);
        SB0();
#pragma unroll
        for (int ks = 0; ks < 8; ++ks) ka[ks] = ldfrag(KA + cn * 4096, ks, lo16);
        SB0();
        f32x16 O;
#pragma unroll
        for (int i = 0; i < 16; ++i) O[i] = 0.f;
        O = mfma32(px0, v0, O); O = mfma32(px1, v1, O);
#pragma unroll
        for (int kt = 0; kt < 4; ++kt) {
            f32x16 Se;
#pragma unroll
            for (int i4 = 0; i4 < 4; ++i4) { const f32x4 er = *(const LAS f32x4*)(decl + 4096 + c * 128 + 32 * kt + 8 * i4 + 4 * h);
#pragma unroll
                for (int e = 0; e < 4; ++e) Se[4 * i4 + e] = S[kt][4 * i4 + e] * er[e]; }
            O = mfma32(qa[kt * 2], packstep(Se, 0), O); O = mfma32(qa[kt * 2 + 1], packstep(Se, 1), O); }
        SB0();
#pragma unroll
        for (int ks = 0; ks < 8; ++ks) qa[ks] = ldfrag(QA + cn * 4096, ks, lo16);
        SB0();
#pragma unroll
        for (int kt = 0; kt < 4; ++kt) {
            f32x4 d[4];
#pragma unroll
            for (int i4 = 0; i4 < 4; ++i4) d[i4] = *(const LAS f32x4*)(decl + c * 128 + 32 * kt + 8 * i4 + 4 * h);
#pragma unroll
            for (int i4 = 0; i4 < 4; ++i4)
#pragma unroll
                for (int e = 0; e < 4; ++e) S[kt][4 * i4 + e] *= d[i4][e];
            S[kt] = mfma32(kb[kt * 2], v0, S[kt]); S[kt] = mfma32(kb[kt * 2 + 1], v1, S[kt]); }
        SB0();
#pragma unroll
        for (int ks = 0; ks < 8; ++ks) kb[ks] = ldfrag(KBT + cn * 4096, ks, lo16);
        v0 = ldfrag(VT + cn * 4096, vs * 2, lo16); v1 = ldfrag(VT + cn * 4096, vs * 2 + 1, lo16);
        SB0();
        float ss[16];
        LAS float* xb = xl + (c & 1) * 256;
        {
#pragma unroll
        for (int i = 0; i < 16; ++i) ss[i] = O[i] * O[i];
        {   const bool b0 = lane & 1, b1 = lane & 2, b2 = lane & 4, b3 = lane & 8;
            float a8[8], a4[4], a2[2];
#pragma unroll
            for (int j = 0; j < 8; ++j) { const float keep = b0 ? ss[2 * j + 1] : ss[2 * j], send = b0 ? ss[2 * j] : ss[2 * j + 1]; a8[j] = keep + dppf<0xB1>(send); }
#pragma unroll
            for (int j = 0; j < 4; ++j) { const float keep = b1 ? a8[2 * j + 1] : a8[2 * j], send = b1 ? a8[2 * j] : a8[2 * j + 1]; a4[j] = keep + dppf<0x4E>(send); }
#pragma unroll
            for (int j = 0; j < 2; ++j) { const float keep = b2 ? a4[2 * j + 1] : a4[2 * j], send = b2 ? a4[2 * j] : a4[2 * j + 1];
                const int si = __builtin_bit_cast(int, send);
                const int t0 = __builtin_amdgcn_update_dpp(si, si, 0x104, 0xf, 0x5, false);
                const int t1 = __builtin_amdgcn_update_dpp(t0, si, 0x114, 0xf, 0xa, false);
                a2[j] = keep + __builtin_bit_cast(float, t1); }
            const float keep = b3 ? a2[1] : a2[0], send = b3 ? a2[0] : a2[1];
            ss[0] = xor16_sum(keep + dppf<0x128>(send));
        }
        if (r < 16) xb[wave * 32 + 8 * (r >> 2) + 4 * h + (r & 3)] = ss[0];
        asm volatile("s_waitcnt lgkmcnt(0)" ::: "memory"); __builtin_amdgcn_s_barrier(); asm volatile("" ::: "memory");
        }
        bf16_t* orow = OA + ((size_t)b * SEQ + g * (CPS * 32) + c * 32) * HGW + hh * 128 + vs * 32;
        const unsigned oo = (unsigned)(4 * h * HGW + r) * 2u;
#pragma unroll
        for (int i4 = 0; i4 < 4; ++i4) {
            f32x4 tot = *(const LAS f32x4*)(xb + (grp * 4 + 0) * 32 + 8 * i4 + 4 * h);
#pragma unroll
            for (int s = 1; s < 4; ++s) tot = tot + *(const LAS f32x4*)(xb + (grp * 4 + s) * 32 + 8 * i4 + 4 * h);
            const float gv[4] = {bflo(gq[i4].x), bfhi(gq[i4].x), bflo(gq[i4].y), bfhi(gq[i4].y)};
#pragma unroll
            for (int e2 = 0; e2 < 2; ++e2) { const int i = 4 * i4 + 2 * e2;
                const float sc0 = __builtin_amdgcn_rsqf(tot[2 * e2] * (1.0f / 128.0f) + EPS) * ogv, sc1 = __builtin_amdgcn_rsqf(tot[2 * e2 + 1] * (1.0f / 128.0f) + EPS) * ogv;
                const unsigned w = cvt_pk_bf16(O[i] * sc0 * gv[2 * e2], O[i + 1] * sc1 * gv[2 * e2 + 1]);
                *(bf16_t*)((char*)(orow + ((i & 3) + 8 * (i >> 2)) * HGW) + oo) = (bf16_t)(w & 0xffffu);
                *(bf16_t*)((char*)(orow + (((i + 1) & 3) + 8 * ((i + 1) >> 2)) * HGW) + oo) = (bf16_t)(w >> 16); } }
#pragma unroll
        for (int i4 = 0; i4 < 4; ++i4) gq[i4] = *(const u32x2*)((const char*)(GF + cn * 4096 + vs * 1024 + i4 * 256) + (lo16 >> 1));
    }
}

DI void attn_task(int b, int kvh, int gq, int qt, int qt_next, int lane, const bf16_t* AQ, bf16x8 (&qf)[4], const LAS unsigned char* kst, const bf16_t* AVT, const float* sinks, bf16_t* OB) {
    const int head = kvh * 4 + gq, r = lane & 31, h = lane >> 5;
    const unsigned lo16 = (unsigned)lane * 16u;
    const bf16_t* qblk = AQ + ((size_t)(b * 8 + head) * 256 + qt_next) * 2048;
    const bf16_t* vbase = AVT + (size_t)(b * 2 + kvh) * 256 * 2048;
    bf16x8 qn[4], kv[5][4];
#pragma unroll
    for (int ks = 0; ks < 4; ++ks) qn[ks] = ldfrag(qblk, ks, lo16);
#pragma unroll
    for (int kt = 0; kt < 5; ++kt)
#pragma unroll
        for (int ks = 0; ks < 4; ++ks) kv[kt][ks] = *(const LAS bf16x8*)(kst + (kt * 4 + ks) * 1024 + lo16);
    const float slope2 = __builtin_amdgcn_exp2f(-(float)(head + 1)) * LOG2E, sink2 = sinks[head] * LOG2E;
    f32x16 X[5];
    float mx = sink2;
    const int rbi = r - 4 * h; float rb = (float)rbi; asm volatile("" : "+v"(rb));
    SB0();
#pragma unroll
    for (int kt = 0; kt < 5; ++kt) {
        f32x16 x;
#pragma unroll
        for (int i = 0; i < 16; ++i) x[i] = 0.f;
#pragma unroll
        for (int ks = 0; ks < 4; ++ks) x = mfma32(kv[kt][ks], qf[ks], x);
        const bool tile_ok = qt - 4 + kt >= 0;
#pragma unroll
        for (int i = 0; i < 16; ++i) { const int ci = (i & 3) + 8 * (i >> 2);
            float v = x[i] - slope2 * (rb + (float)(128 - 32 * kt - ci));
            if (kt == 0 && !(ci > rbi)) v = -1e30f;
            if (kt == 4 && !(ci <= rbi)) v = -1e30f;
            if (!tile_ok) v = -1e30f;
            x[i] = v; mx = fmaxf(mx, v); }
        X[kt] = x;
    }
    SB0();
#pragma unroll
    for (int kt = 0; kt < 5; ++kt) { const int vn = qt - 4 + kt < 0 ? 0 : qt - 4 + kt;
#pragma unroll
        for (int f = 0; f < 4; ++f) kv[kt][f] = ldfrag(vbase + vn * 2048, f, lo16); }
    SB0();
    mx = xor32_max(mx);
    float l = 0.f;
#pragma unroll
    for (int kt = 0; kt < 5; ++kt)
#pragma unroll
        for (int i = 0; i < 16; ++i) { const float p = __builtin_amdgcn_exp2f(X[kt][i] - mx); X[kt][i] = p; l += p; }
    l = xor32_sum(l);
    l += __builtin_amdgcn_exp2f(sink2 - mx);
    f32x16 O[2];
#pragma unroll
    for (int dt = 0; dt < 2; ++dt)
#pragma unroll
        for (int i = 0; i < 16; ++i) O[dt][i] = 0.f;
    SB0();
#pragma unroll
    for (int kt = 0; kt < 5; ++kt) {
#pragma unroll
        for (int ks = 0; ks < 2; ++ks) { const bf16x8 pf = packstep(X[kt], ks);
#pragma unroll
            for (int dt = 0; dt < 2; ++dt) O[dt] = mfma32(pf, kv[kt][dt * 2 + ks], O[dt]); }
    }
    SB0();
    const float linv = __builtin_amdgcn_rcpf(l);
    bf16_t* orow = OB + ((size_t)b * SEQ + qt * 32) * ATW + head * 64;
    const unsigned oo = (unsigned)(4 * h * ATW + r) * 2u;
#pragma unroll
    for (int i = 0; i < 16; ++i) { const int t = crow(i, h); const float li = __shfl(linv, t);
        { const unsigned w = cvt_pk_bf16(O[0][i] * li, O[1][i] * li);
          *(bf16_t*)((char*)(orow + ((i & 3) + 8 * (i >> 2)) * ATW) + oo) = (bf16_t)(w & 0xffffu); *(bf16_t*)((char*)(orow + ((i & 3) + 8 * (i >> 2)) * ATW + 32) + oo) = (bf16_t)(w >> 16); } }
#pragma unroll
    for (int ks = 0; ks < 4; ++ks) qf[ks] = qn[ks];
}

#define XB_TMO      128
#define XB_XCNT(j)  (256  + 64 * (j))
#define XB_XSUB(j)  (1280 + 64 * (j))
#define XB_XGEN(j)  (2304 + 64 * (j))
#define XB_TOP      3328
#define XB_TOPGEN   3392
#define XCD_BAR_WORDS 3456
#define XB_SPIN_CAP (1u << 18)
DI unsigned xb_ld(unsigned* p)              { return __hip_atomic_load(p, __ATOMIC_RELAXED, __HIP_MEMORY_SCOPE_AGENT); }
DI unsigned xb_add(unsigned* p, unsigned v) { return __hip_atomic_fetch_add(p, v, __ATOMIC_RELAXED, __HIP_MEMORY_SCOPE_AGENT); }
DI unsigned xb_xcc_id() { return (unsigned)__builtin_amdgcn_s_getreg((3 << 11) | 20) & 0xFu; }
#define XB_SPIN(cond, bar) do { unsigned _sp = 0; while (cond) { __builtin_amdgcn_s_sleep(1); \
    if ((++_sp & 255u) == 0u) { if (xb_ld(&(bar)[XB_TMO])) break; if (_sp > XB_SPIN_CAP) { atomicAdd(&(bar)[XB_TMO], 1u); break; } } } } while (0)
struct XcdBarrier { unsigned* bar; unsigned x; };
DI XcdBarrier xcd_barrier_post(unsigned* bar) {
    XcdBarrier b; b.bar = bar; b.x = xb_xcc_id();
    if (threadIdx.x == 0) (void)xb_add(&bar[XB_XCNT(b.x)], 1u);
    return b;
}
DI void xcd_barrier_complete(unsigned* bar, unsigned x, unsigned& nloc, unsigned& nx) {
    const unsigned G = gridDim.x * gridDim.y * gridDim.z;
    unsigned sum, cnt, mine, sp = 0u;
    for (;;) {
        sum = 0u; cnt = 0u; mine = 0u;
#pragma unroll
        for (unsigned j = 0; j < 16; ++j) { const unsigned c = xb_ld(&bar[XB_XCNT(j)]); sum += c; cnt += (c > 0u) ? 1u : 0u; mine = (j == x) ? c : mine; }
        if (sum == G) break;
        __builtin_amdgcn_s_sleep(1);
        if ((++sp & 255u) == 0u) { if (xb_ld(&bar[XB_TMO])) break; if (sp > XB_SPIN_CAP) { atomicAdd(&bar[XB_TMO], 1u); break; } }
    }
    nloc = mine > 0u ? mine : 1u; nx = cnt > 0u ? cnt : 1u;
}
DI void xcd_barrier(const XcdBarrier& b, const bool leader, unsigned& nloc, unsigned& nx) {
    asm volatile("s_waitcnt vmcnt(0)" ::: "memory");
    __syncthreads();
    if (leader) {
        unsigned* bar = b.bar;
        __builtin_amdgcn_s_waitcnt(0);
        if (nloc == 0u) xcd_barrier_complete(bar, b.x, nloc, nx);
        const unsigned old = xb_add(&bar[XB_XSUB(b.x)], 1u);
        const unsigned gen = old / nloc;
        if (old + 1u == (gen + 1u) * nloc) {
            __builtin_amdgcn_fence(__ATOMIC_RELEASE, "agent");
            asm volatile("s_waitcnt vmcnt(0)" ::: "memory");
            const unsigned og = xb_add(&bar[XB_TOP], 1u);
            const unsigned tg = og / nx;
            if (og + 1u == (tg + 1u) * nx) xb_add(&bar[XB_TOPGEN], 1u);
            else XB_SPIN(xb_ld(&bar[XB_TOPGEN]) == tg, bar);
            __builtin_amdgcn_fence(__ATOMIC_ACQUIRE, "agent");
            xb_add(&bar[XB_XGEN(b.x)], 1u);
            asm volatile("s_waitcnt vmcnt(0)" ::: "memory");
        } else {
            XB_SPIN(xb_ld(&bar[XB_XGEN(b.x)]) == gen, bar);
            __builtin_amdgcn_fence(__ATOMIC_ACQUIRE, "agent");
            asm volatile("s_waitcnt vmcnt(0)" ::: "memory");
        }
    }
    __syncthreads();
}

struct Args { const float* in[16]; float* out; unsigned char* ws; int ph_lo, ph_hi; };
constexpr int N_PHASES = 8;

__global__ void __launch_bounds__(NTHREADS, 2) fwd(Args args) {
    extern __shared__ __attribute__((aligned(16))) unsigned char lds_raw[];
    LAS unsigned char* lds = (LAS unsigned char*)lds_raw;
    const int wave = __builtin_amdgcn_readfirstlane(threadIdx.x >> 6);
    const int G = gridDim.x, bx = blockIdx.x;
    const int gw = bx * 8 + wave, NGW = G * 8;
    unsigned char* const ws = args.ws;
#define WSP(T, off) ((T*)(ws + (off)))

    const int lo = args.ph_lo, hi = args.ph_hi;
#define IN(k) (lo <= (k) && (k) < hi)
#define SEAM(k) do { if (IN(k) && IN((k) + 1)) { xcd_barrier(xbar, wave == 0 && lane_id() == 0, xb_nloc, xb_nx); xb_nloc = __builtin_amdgcn_readfirstlane(xb_nloc); xb_nx = __builtin_amdgcn_readfirstlane(xb_nx); } } while (0)
    unsigned xb_nloc = 0u, xb_nx = 0u;
    const XcdBarrier xbar = xcd_barrier_post((unsigned*)ws);

    if (IN(0)) {
        const int lane = lane_id(), tid = wave * 64 + lane;
        const float* x = args.in[0];
        bf16_t* WIN = WSP(bf16_t, WS_WIN); bf16_t* WA = WSP(bf16_t, WS_WA); bf16_t* WB = WSP(bf16_t, WS_WB); bf16_t* WOUT = WSP(bf16_t, WS_WOUT); bf16_t* WUP = WSP(bf16_t, WS_WUP); bf16_t* WDOWN = WSP(bf16_t, WS_WDOWN);
        bf16_t* XB = WSP(bf16_t, WS_XB); float* RMS1 = WSP(float, WS_RSTD1); float* SUMSQ2 = WSP(float, WS_SUMSQ2); float* LB = WSP(float, WS_LB);
        LAS float* scr = (LAS float*)(lds + wave * 16384);
        constexpr int I_IN = 16 * 152, I_A = 8 * 32, I_B = 8 * 32, I_OUT = 16 * 32, I_UP = 16 * 176, I_DN = 44 * 32;
        constexpr int NITEMS = I_IN + I_A + I_B + I_OUT + I_UP + I_DN;
        for (int pass = 0; pass < 2; ++pass) {
        if (((pass ^ wave) & 1) == 0) {
        for (int it = gw; it < NITEMS; it += NGW) {
            int r = it;
            if (r < I_IN) { const int kb = r / 152, nb = r % 152; transpose_item(args.in[2], DM, INC, colmap_in(32 * nb), WIN, 32 * nb, 64 * kb, args.in[1], scr, lane, in_colscale(32 * nb)); continue; } r -= I_IN;
            if (r < I_A) { const int kb = r / 32, nb = r % 32; transpose_item(args.in[8], 512, DM, 32 * nb, WA, 32 * nb, 64 * kb, nullptr, scr, lane); continue; } r -= I_A;
            if (r < I_B) { const int kb = r / 32, nb = r % 32; transpose_item(args.in[9], 512, DM, 32 * nb, WB, 32 * nb, 64 * kb, nullptr, scr, lane); continue; } r -= I_B;
            if (r < I_OUT) { const int kb = r / 32, nb = r % 32; transpose_item(args.in[10], DM, DM, 32 * nb, WOUT, 32 * nb, 64 * kb, nullptr, scr, lane); continue; } r -= I_OUT;
            if (r < I_UP) { const int kb = r / 176, nb = r % 176; transpose_item(args.in[12], DM, 2 * DFF, colmap_up(32 * nb), WUP, 32 * nb, 64 * kb, args.in[11], scr, lane); continue; } r -= I_UP;
            { const int kb = r / 32, nb = r % 32; transpose_item(args.in[15], DFF, DM, 32 * nb, WDOWN, 32 * nb, 64 * kb, nullptr, scr, lane); }
        }
        } else {
        for (int m0 = gw * 4; m0 < MTOK; m0 += NGW * 4) {
            f32x4 v[4][4]; float s[4];
#pragma unroll
            for (int q = 0; q < 4; ++q) { const f32x4* xr = (const f32x4*)(x + (size_t)(m0 + q) * DM) + lane;
#pragma unroll
                for (int j = 0; j < 4; ++j) v[q][j] = xr[64 * j]; }
#pragma unroll
            for (int q = 0; q < 4; ++q) { float a = 0.f;
#pragma unroll
                for (int j = 0; j < 4; ++j) a += (v[q][j].x * v[q][j].x + v[q][j].y * v[q][j].y) + (v[q][j].z * v[q][j].z + v[q][j].w * v[q][j].w);
                s[q] = a; }
#pragma unroll
            for (int o = 1; o < 64; o <<= 1)
#pragma unroll
                for (int q = 0; q < 4; ++q) s[q] += __shfl_xor(s[q], o);
#pragma unroll
            for (int q = 0; q < 4; ++q) { u32x2* o8 = (u32x2*)(XB + (size_t)(m0 + q) * DM) + lane; const float rs = __builtin_amdgcn_rsqf(s[q] * (1.0f / DM) + EPS);
#pragma unroll
                for (int j = 0; j < 4; ++j) { u32x2 w; w.x = cvt_pk_bf16(v[q][j].x * rs, v[q][j].y * rs); w.y = cvt_pk_bf16(v[q][j].z * rs, v[q][j].w * rs); o8[64 * j] = w; } }
            if (lane < 4) { const float sq = lane == 0 ? s[0] : lane == 1 ? s[1] : lane == 2 ? s[2] : s[3]; RMS1[m0 + lane] = __builtin_sqrtf(sq * (1.0f / DM) + EPS); SUMSQ2[m0 + lane] = 0.f; }
        }
        }
        }
        if (bx == 0) { const float l0 = args.in[3][tid], l1 = args.in[3][512 + tid]; LB[tid] = 1.0f / (1.0f + expf(l1 - l0)); }
    }
    SEAM(0);

    if (IN(1)) {
        SchedPlain S; S.T.init(MTOK / 256, INC / 256, G, bx); S.A = (const char*)(ws + WS_XB); S.Bt = (const char*)(ws + WS_WIN); S.atile = (size_t)256 * DM * 2; S.btile = (size_t)256 * DM * 2;
        EpiIn E{args.in[5], args.in[6], ws, lds, wave};
        pg8::gemm_phase<EpiIn, SchedPlain, 1>(lds, wave, DM, S, E);
    }
    SEAM(1);

    const int gi = bx * 2 + (wave >> 2), vs = wave & 3;
    if (IN(2)) {
        const int lane = lane_id();
        for (int slot = gw >> 2; slot < NB * 2 * 32; slot += NGW >> 2) {
            const int qg = slot & 31, kvh = (slot >> 5) & 1, b = slot >> 6;
            LAS unsigned char* kgrp = lds + (wave >> 2) * 49152;
            { const bf16_t* kbase = WSP(bf16_t, WS_AK) + (size_t)(b * 2 + kvh) * 256 * 2048;
#pragma unroll
              for (int k = 0; k < 12; ++k) { const int pce = (wave & 3) * 12 + k, tl = qg * 8 - 4 + (pce >> 2), kn = tl < 0 ? 0 : tl;
                  __builtin_amdgcn_global_load_lds((const unsigned*)((const char*)(kbase + (size_t)kn * 2048 + (pce & 3) * 512) + (unsigned)lane * 16u), (LAS unsigned*)(kgrp + pce * 1024), 16, 0, 0); }
              asm volatile("s_waitcnt vmcnt(0)" ::: "memory"); __syncthreads(); }
            bf16x8 qf[4];
            { const bf16_t* q0 = WSP(bf16_t, WS_AQ) + ((size_t)(b * 8 + kvh * 4 + (wave & 3)) * 256 + qg * 8) * 2048;
#pragma unroll
              for (int ks = 0; ks < 4; ++ks) qf[ks] = ldfrag(q0, ks, (unsigned)lane * 16u); }
            for (int it = 0; it < 8; ++it) attn_task(b, kvh, wave & 3, qg * 8 + it, qg * 8 + (it < 7 ? it + 1 : 7), lane, WSP(bf16_t, WS_AQ), qf, kgrp + it * 4096, WSP(bf16_t, WS_AV), args.in[7], WSP(bf16_t, WS_OB));
            __syncthreads();
        }
        LAS float* decl = (LAS float*)(lds + 4096) + (wave >> 2) * 2048;
        stage_vec(decl, WSP(float, WS_DEC), gi, vs, lane);
        __syncthreads();
        scan_pass_a(gi, vs, lane, lds, decl, WSP(bf16_t, WS_KBT), WSP(bf16_t, WS_VT), WSP(float, WS_DEC), WSP(float, WS_SLOC), WSP(float, WS_DSEG));
    }
    SEAM(2);

    if (IN(3)) {
        { LAS float* decl = (LAS float*)(lds + 4096) + (wave >> 2) * 2048; const int l_ = lane_id(); stage_vec(decl, WSP(float, WS_DEC), gi, vs, l_); stage_vec(decl + 4096, WSP(float, WS_EREF), gi, vs, l_); __syncthreads(); }
        scan_pass_b(gi, vs, wave, lane_id(), (LAS float*)lds, (LAS float*)(lds + 4096) + (wave >> 2) * 2048, WSP(bf16_t, WS_KA), WSP(bf16_t, WS_QA), WSP(bf16_t, WS_KBT), WSP(bf16_t, WS_VT), WSP(float, WS_DEC),
                    WSP(float, WS_SLOC), WSP(float, WS_DSEG), WSP(bf16_t, WS_G), args.in[4], WSP(bf16_t, WS_OA));
    }
    SEAM(3);

    if (IN(4)) {
        SchedPair S; S.T.init(MTOK / 256, DM / 256, G, bx); S.A0 = (const char*)(ws + WS_OA); S.A1 = (const char*)(ws + WS_OB); S.B0 = (const char*)(ws + WS_WA); S.B1 = (const char*)(ws + WS_WB); S.atile = (size_t)256 * 512 * 2; S.btile = (size_t)256 * 512 * 2;
        EpiBranch E{WSP(unsigned char, WS_GA), WSP(unsigned char, WS_GB), WSP(bf16_t, WS_MIXED)};
        pg8::gemm_phase<EpiBranch, SchedPair, 1>(lds, wave, 512, S, E);
    }
    SEAM(4);

    if (IN(5)) {
        SchedPlain S; S.T.init(MTOK / 256, DM / 256, G, bx); S.A = (const char*)(ws + WS_MIXED); S.Bt = (const char*)(ws + WS_WOUT); S.atile = (size_t)256 * DM * 2; S.btile = (size_t)256 * DM * 2;
        EpiOut E{WSP(bf16_t, WS_XB), WSP(float, WS_RSTD1), WSP(bf16_t, WS_X1B), WSP(float, WS_SUMSQ2)};
        pg8::gemm_phase<EpiOut, SchedPlain, 0>(lds, wave, DM, S, E);
    }
    SEAM(5);

    if (IN(6)) {
        SchedUp S; S.T.init(P4_NM, (2 * DFF) / 256, G, bx); S.A = (const char*)(ws + WS_X1B); S.Bt = (const char*)(ws + WS_WUP); S.btile = (size_t)256 * DM * 2;
        EpiUp E{WSP(float, WS_SUMSQ2), args.in[13], args.in[14], WSP(bf16_t, WS_ACT), lds};
        pg8::gemm_phase<EpiUp, SchedUp, 2>(lds, wave, DM, S, E);
    }
    SEAM(6);

    if (IN(7)) {
        SchedPlain S; S.T.init(MTOK / 256, DM / 256, G, bx); S.A = (const char*)(ws + WS_ACT); S.Bt = (const char*)(ws + WS_WDOWN); S.atile = (size_t)256 * DFF * 2; S.btile = (size_t)256 * DFF * 2;
        EpiDown E{WSP(bf16_t, WS_X1B), args.out};
        pg8::gemm_phase<EpiDown, SchedPlain, 0>(lds, wave, DFF, S, E);
    }
#undef IN
#undef SEAM
}

extern "C" void kernel_launch(void* const* d_in, const int* in_sizes, int n_in, void* d_out, int out_size, void* d_ws, size_t ws_size, hipStream_t stream) {
    static int grid = 0;
    if (grid == 0) {
        if (n_in != 16 || out_size != MTOK * DM || ws_size < WS_END) { fprintf(stderr, "kernel_launch: unexpected shapes (n_in %d out %d ws %zu)\n", n_in, out_size, ws_size); grid = -1; return; }
        int dev = 0, cus = 0, per_cu = 0;
        hipGetDevice(&dev);
        hipDeviceGetAttribute(&cus, hipDeviceAttributeMultiprocessorCount, dev);
        hipFuncSetAttribute((const void*)fwd, hipFuncAttributeMaxDynamicSharedMemorySize, LDS_BYTES);
        hipOccupancyMaxActiveBlocksPerMultiprocessor(&per_cu, (const void*)fwd, NTHREADS, LDS_BYTES);
        if (per_cu < 1) { fprintf(stderr, "kernel_launch: occupancy query says %d blocks per CU\n", per_cu); per_cu = 1; }
        (void)hipGetLastError();
        grid = cus * 1;
    }
    if (grid < 0) return;
    if (hipMemsetAsync(d_ws, 0, 65536, stream) != hipSuccess) { fprintf(stderr, "kernel_launch: memset of the barrier words failed\n"); return; }
    Args a{};
    for (int i = 0; i < 16; ++i) a.in[i] = (const float*)d_in[i];
    a.out = (float*)d_out; a.ws = (unsigned char*)d_ws;
#if MK_N_LAUNCHES == 1
    a.ph_lo = 0; a.ph_hi = N_PHASES;
    void* kargs[] = {&a};
    hipError_t e = hipLaunchCooperativeKernel((const void*)fwd, dim3(grid), dim3(NTHREADS), kargs, LDS_BYTES, stream);
    if (e != hipSuccess) fprintf(stderr, "kernel_launch: cooperative launch failed: %s (grid %d)\n", hipGetErrorString(e), grid);
#else
    for (int p = 0; p < N_PHASES; ++p) { a.ph_lo = p; a.ph_hi = p + 1; hipLaunchKernelGGL(fwd, dim3(grid), dim3(NTHREADS), LDS_BYTES, stream, a); }
#endif
}
```

```cpp
#include <hip/hip_runtime.h>
#include <cstdio>
#include <cstdint>

#define LAS __attribute__((address_space(3)))
#define DI __device__ __forceinline__
typedef unsigned short bf16_t;
typedef short bf16x8 __attribute__((ext_vector_type(8)));
typedef float f32x4 __attribute__((ext_vector_type(4)));
typedef float f32x2 __attribute__((ext_vector_type(2)));
typedef float f32x16 __attribute__((ext_vector_type(16)));
typedef unsigned u32x4 __attribute__((ext_vector_type(4)));
typedef unsigned u32x2 __attribute__((ext_vector_type(2)));


#ifndef MK_N_LAUNCHES
#define MK_N_LAUNCHES 1
#endif

constexpr int DM = 1024, NB = 8, SEQ = 8192, MTOK = NB * SEQ;
constexpr int INC = 4864, DFF = 2816, HGW = 512, ATW = 512, AKW = 128;
constexpr int HG_Q0 = 0, HG_F0 = 512, HG_I0 = 1024, HG_G0 = 1536, AT_Q0 = 2048, AT_K0 = 2560, AT_V0 = 2688, GATE_A0 = 2816, GATE_B0 = 3840;
constexpr float EPS = 1e-6f;
constexpr float LOG2E = 1.4426950408889634f;
constexpr float QSCALE = 0.125f * LOG2E;
constexpr int P4_TPS = 33;
constexpr int P4_NM = NB * P4_TPS;

constexpr size_t MiB = 1u << 20;
constexpr size_t WS_SMALL = 1 * MiB;
constexpr size_t WS_RSTD1 = WS_SMALL, WS_SUMSQ2 = WS_SMALL + 256 * 1024, WS_LB = WS_SMALL + 512 * 1024;
constexpr size_t WS_WIN = 2 * MiB;
constexpr size_t WS_WA = 12 * MiB;
constexpr size_t WS_WB = 13 * MiB;
constexpr size_t WS_WOUT = 14 * MiB;
constexpr size_t WS_WUP = 16 * MiB;
constexpr size_t WS_WDOWN = 28 * MiB;
constexpr size_t WS_XB = 36 * MiB;
constexpr size_t WS_OA = 937 * MiB, WS_OB = 292 * MiB;
constexpr size_t WS_KA = 164 * MiB;
constexpr size_t WS_QA = 228 * MiB;
constexpr size_t WS_X1B = 356 * MiB;
constexpr size_t WS_EREF = 1001 * MiB;
constexpr size_t WS_KBT = 356 * MiB;
constexpr size_t WS_MIXED = 164 * MiB;
constexpr size_t WS_G = 420 * MiB;
constexpr size_t WS_AQ = 484 * MiB;
constexpr size_t WS_AK = 548 * MiB;
constexpr size_t WS_AV = 564 * MiB;
constexpr size_t WS_GA = 580 * MiB;
constexpr size_t WS_GB = 708 * MiB;
constexpr size_t WS_VT = 836 * MiB;
constexpr size_t WS_DEC = 900 * MiB;
constexpr size_t WS_SLOC = 904 * MiB;
constexpr size_t WS_DSEG = 936 * MiB;
constexpr size_t WS_ACT = 580 * MiB;
constexpr size_t WS_END = 1024 * MiB;
constexpr int NSEG = 16, CPS = 16;

constexpr int LDS_BYTES = 163840;
constexpr int STG_OFF = 131072;
constexpr int NTHREADS = 512;

DI unsigned f2bf(float f) { unsigned u = __builtin_bit_cast(unsigned, f); return (u + 0x7fffu + ((u >> 16) & 1u)) >> 16; }
DI unsigned pk2(float lo, float hi) { return f2bf(lo) | (f2bf(hi) << 16); }
DI float bf2f(unsigned short b) { return __builtin_bit_cast(float, (unsigned)b << 16); }
DI float bflo(unsigned w) { return __builtin_bit_cast(float, w << 16); }
DI float bfhi(unsigned w) { return __builtin_bit_cast(float, w & 0xffff0000u); }
typedef __bf16 bf16x2_t __attribute__((ext_vector_type(2)));
DI unsigned cvt_pk_bf16(float lo, float hi) { f32x2 v = {lo, hi}; bf16x2_t b = __builtin_convertvector(v, bf16x2_t); return __builtin_bit_cast(unsigned, b); }
DI float fexp(float x) { return __builtin_amdgcn_exp2f(x * LOG2E); }
DI float sigmoidf_(float x) { return __builtin_amdgcn_rcpf(1.0f + fexp(-x)); }
DI float siluf_(float x) { return x * sigmoidf_(x); }
DI float sig2(float a) { return __builtin_amdgcn_rcpf(1.0f + __builtin_amdgcn_exp2f(a)); }
constexpr float NLN2 = -0.6931471805599453f;
DI float in_colscale(int n) { const int t = n >> 8; return (t < 4 || t == 6 || t == 7 || t >= 11) ? -LOG2E : 1.0f; }
DI int lane_id() { int l; asm volatile("v_mbcnt_lo_u32_b32 %0, -1, 0\n\tv_mbcnt_hi_u32_b32 %0, -1, %0" : "=v"(l)); return l; }
template <int CTRL> DI float dppf(float x) { return __builtin_bit_cast(float, __builtin_amdgcn_update_dpp(__builtin_bit_cast(int, x), __builtin_bit_cast(int, x), CTRL, 0xf, 0xf, false)); }
DI float xor16_sum(float x) { float a = x, b = x; asm volatile("s_nop 1\n\tv_permlane16_swap_b32 %0, %1" : "+v"(a), "+v"(b)); return a + b; }
DI float xor32_sum(float x) { float a = x, b = x; asm volatile("s_nop 1\n\tv_permlane32_swap_b32 %0, %1" : "+v"(a), "+v"(b)); return a + b; }
DI float xor32_max(float x) { float a = x, b = x; asm volatile("s_nop 1\n\tv_permlane32_swap_b32 %0, %1" : "+v"(a), "+v"(b)); return fmaxf(a, b); }
DI float wave_sum(float v) {
#pragma unroll
    for (int o = 1; o < 64; o <<= 1) v += __shfl_xor(v, o);
    return v;
}
DI u32x4 pack8(const f32x4& a, const f32x4& b) { u32x4 w; w.x = cvt_pk_bf16(a[0], a[1]); w.y = cvt_pk_bf16(a[2], a[3]); w.z = cvt_pk_bf16(b[0], b[1]); w.w = cvt_pk_bf16(b[2], b[3]); return w; }
DI void unpack8(const u32x4& w, f32x4& a, f32x4& b) { a = (f32x4){bflo(w.x), bfhi(w.x), bflo(w.y), bfhi(w.y)}; b = (f32x4){bflo(w.z), bfhi(w.z), bflo(w.w), bfhi(w.w)}; }
DI f32x2 gelu_pk(f32x2 v) {
    const f32x2 av = __builtin_elementwise_abs(v), d = av * 0.2316418882f + 1.0f;
    f32x2 t; t.x = __builtin_amdgcn_rcpf(d.x); t.y = __builtin_amdgcn_rcpf(d.y);
    f32x2 q = t * 0.5307027145f + (-0.7265760135f); q = q * t + 0.7107068705f; q = q * t + (-0.142248368f); q = q * t + 0.127414796f; q = q * t;
    const f32x2 s = (v * v) * (-0.72134752044f);
    f32x2 e; e.x = __builtin_amdgcn_exp2f(s.x); e.y = __builtin_amdgcn_exp2f(s.y);
    const f32x2 m = av * (q * e);
    f32x2 o; o.x = fmaxf(v.x, 0.f) - m.x; o.y = fmaxf(v.y, 0.f) - m.y; return o;
}

namespace pg8 {
constexpr int BM = 256, BK = 64, HALF = 128, HTB = HALF * BK * 2, STAGE_BYTES = 8 * HTB, NXCD = 8, WGM = 8;
__host__ __device__ __forceinline__ int lds_byte(int r, int c) { const int st = (r >> 4) * 2 + (c >> 5), rr = r & 15, cc = c & 31, ob = rr * 64 + cc * 2; return st * 1024 + (ob ^ (((ob >> 9) & 1) << 5)); }
__host__ __device__ __forceinline__ void stage_rc(int b, int& R, int& C) { const int st = b / 1024, sb = b % 1024, swz = sb ^ (((sb >> 9) & 1) << 5); R = (st >> 1) * 16 + swz / 64; C = (st & 1) * 32 + (swz % 64) / 2; }
__host__ __device__ __forceinline__ int perm32(int rho) { const int n = rho >> 4, i = rho & 15; return 8 * (i >> 2) + 4 * n + (i & 3); }

struct Unit { int pm, pn, part; };

struct TileOrder {
    int nM, nN, nwg, G, c;
    DI void init(int nM_, int nN_, int G_, int c_) { nM = nM_; nN = nN_; nwg = nM * nN; G = G_; c = c_; }
    DI bool tile(int i, int& pm, int& pn) const {
        const long L = (long)i * G + c; if (L >= nwg) return false;
        int wgid = (int)L; { const int q = nwg / NXCD, r = nwg % NXCD, xcd = wgid % NXCD, off = wgid / NXCD; wgid = (xcd < r ? xcd * (q + 1) : r * (q + 1) + (xcd - r) * q) + off; }
        const int nig = WGM * nN, gid = wgid / nig, fm = gid * WGM, gsz = (nM - fm) < WGM ? (nM - fm) : WGM;
        pm = fm + ((wgid % nig) % gsz); pn = (wgid % nig) / gsz; return true;
    }
};

template <int RM> DI int arow_of(int R) {
    if (RM == 0) return R;
    if (RM == 1) return 128 * (R >> 6) + 8 * (R & 15) + ((R >> 4) & 3);
    return 126 * (R >> 6) + 8 * (R & 15) + ((R >> 4) & 3);
}
template <int RM> constexpr int ahalf_rows() { return RM == 0 ? 128 : 4; }

template <class Epi, class Sched, int RM>
DI void gemm_phase(LAS unsigned char* lds, const int wid, const int K, const Sched& S, const Epi& E) {
    const int lane = lane_id(), tid = wid * 64 + lane, wr = wid >> 2, wc = wid & 3, fr = lane & 15, fq = lane >> 4;
    const int nt = K / BK;
    unsigned voffA[2], voffB[2];
#pragma unroll
    for (int i = 0; i < 2; ++i) { int R, C; stage_rc(tid * 16 + i * 8192, R, C); const int Rb = Epi::PERM ? ((R & ~31) + perm32(R & 31)) : R;
        voffA[i] = (unsigned)(arow_of<RM>(R) * K + C) * 2u; voffB[i] = (unsigned)(Rb * K + C) * 2u; }
    const size_t kstep = (size_t)(BK * 2);
    const size_t hstepA = (size_t)ahalf_rows<RM>() * K * 2, hstepB = (size_t)HALF * K * 2;
    const unsigned ldsw = (unsigned)wid * 1024u;
    const int aoff = lds_byte(wr * 64 + fr, fq * 8), boff = lds_byte(wc * 32 + fr, fq * 8);
#define PG8_SA(b, h) (((b) * 2 + (h)) * HTB)
#define PG8_SB(b, h) ((4 + (b) * 2 + (h)) * HTB)
#define PG8_STAGE(bufoff, gbase, voff) do { const char* _g = (const char*)(gbase); const unsigned _l0 = (unsigned)(size_t)(lds + (bufoff)) + ldsw; \
        asm volatile("s_mov_b32 m0, %3\n\ts_nop 0\n\tglobal_load_lds_dwordx4 %0, %2\n\ts_mov_b32 m0, %4\n\ts_nop 0\n\tglobal_load_lds_dwordx4 %1, %2" \
                     :: "v"((voff)[0]), "v"((voff)[1]), "s"(_g), "s"(_l0), "s"(_l0 + 8192u) : "memory", "m0"); } while (0)
#define PG8_LDA(dst, b, h) do { _Pragma("unroll") for (int m = 0; m < 4; ++m) _Pragma("unroll") for (int k = 0; k < 2; ++k) dst[m][k] = *(const LAS bf16x8*)(lds + PG8_SA(b, h) + aoff + m * 2048 + k * 1024); } while (0)
#define PG8_LDB(dst, b, h) do { _Pragma("unroll") for (int n = 0; n < 2; ++n) _Pragma("unroll") for (int k = 0; k < 2; ++k) dst[n][k] = *(const LAS bf16x8*)(lds + PG8_SB(b, h) + boff + n * 2048 + k * 1024); } while (0)
#define PG8_MMA(ai, bj, At, Bt) do { __builtin_amdgcn_s_setprio(1); _Pragma("unroll") for (int m = 0; m < 4; ++m) _Pragma("unroll") for (int n = 0; n < 2; ++n) _Pragma("unroll") for (int k = 0; k < 2; ++k) \
        acc[ai][bj][m][n] = __builtin_amdgcn_mfma_f32_16x16x32_bf16(Bt[n][k], At[m][k], acc[ai][bj][m][n], 0, 0, 0); __builtin_amdgcn_s_setprio(0); } while (0)
#define PG8_WAIT_V(n) asm volatile("s_waitcnt vmcnt(" #n ")" ::: "memory")
#define PG8_WAIT_L(n) asm volatile("s_waitcnt lgkmcnt(" #n ")" ::: "memory")
#define PG8_WAIT_VX(base) do { if constexpr (Epi::SX > 0) asm volatile("s_cmp_lg_u32 %0, 0\n\ts_cbranch_scc1 1f\n\ts_waitcnt vmcnt(%2)\n1:\n\ts_waitcnt vmcnt(%1)" :: "s"(sx), "n"((base) + Epi::SX), "n"(base) : "memory", "scc"); else asm volatile("s_waitcnt vmcnt(%0)" :: "n"(base) : "memory"); } while (0)
#define PG8_BAR __builtin_amdgcn_s_barrier()
#define PG8_SCHED __builtin_amdgcn_sched_barrier(0)
    Unit cur, nxt; int ui = 0, sxn = 0;
    if (!S.next(0, cur)) return;
    f32x4 acc[2][2][4][2];
#pragma unroll
    for (int a = 0; a < 2; ++a)
#pragma unroll
        for (int b = 0; b < 2; ++b)
#pragma unroll
            for (int m = 0; m < 4; ++m)
#pragma unroll
                for (int n = 0; n < 2; ++n) acc[a][b][m][n] = (f32x4){0.f, 0.f, 0.f, 0.f};
    bf16x8 At[4][2], B0[2][2], B1e[2][2], B1o[2][2];
    const char* cA = S.abase(cur); const char* cB = S.bbase(cur);
    PG8_STAGE(PG8_SB(0, 0), cB, voffB); PG8_STAGE(PG8_SB(0, 1), cB + hstepB, voffB); PG8_STAGE(PG8_SA(0, 0), cA, voffA); PG8_STAGE(PG8_SA(0, 1), cA + hstepA, voffA);
    PG8_STAGE(PG8_SB(1, 1), cB + hstepB + kstep, voffB); PG8_STAGE(PG8_SB(1, 0), cB + kstep, voffB); PG8_STAGE(PG8_SA(1, 0), cA + kstep, voffA);
    if (wr == 1) PG8_BAR;
    PG8_WAIT_V(0); PG8_BAR;
    PG8_BAR;
    for (;;) {
        const bool has_next = S.next(ui + 1, nxt);
        const char* nA = has_next ? S.abase(nxt) : cA; const char* nB = has_next ? S.bbase(nxt) : cB;
#define PG8_PAIR() do { \
              PG8_LDB(B0, 0, 0); PG8_SCHED; PG8_LDA(At, 0, 0); PG8_STAGE(PG8_SA(1, 1), a1 + hstepA, voffA); PG8_STAGE(PG8_SB(0, 1), b2 + hstepB, voffB); \
            PG8_WAIT_V(8); PG8_WAIT_L(0); PG8_BAR; PG8_MMA(0, 0, At, B0); PG8_MMA(0, 1, At, B1e); PG8_BAR; PG8_SCHED; \
              PG8_LDA(At, 0, 1); PG8_LDB(B1o, 1, 1); PG8_STAGE(PG8_SB(0, 0), b2, voffB); PG8_STAGE(PG8_SA(0, 0), a2, voffA); \
            PG8_WAIT_V(8); PG8_WAIT_L(0); PG8_BAR; PG8_MMA(1, 0, At, B0); PG8_MMA(1, 1, At, B1e); PG8_BAR; PG8_SCHED; \
            PG8_PAIR_TAIL(); } while (0)
#define PG8_PAIR_TAIL() do { \
              PG8_LDB(B0, 1, 0); PG8_SCHED; PG8_LDA(At, 1, 0); PG8_STAGE(PG8_SA(0, 1), a2 + hstepA, voffA); PG8_STAGE(PG8_SB(1, 1), b3 + hstepB, voffB); \
            PG8_WAIT_V(8); PG8_WAIT_L(0); PG8_BAR; PG8_MMA(0, 0, At, B0); PG8_MMA(0, 1, At, B1o); PG8_BAR; PG8_SCHED; \
              PG8_LDA(At, 1, 1); PG8_LDB(B1e, 0, 1); PG8_STAGE(PG8_SB(1, 0), b3, voffB); PG8_STAGE(PG8_SA(1, 0), a3, voffA); \
            PG8_WAIT_V(8); PG8_WAIT_L(0); PG8_BAR; PG8_MMA(1, 0, At, B0); PG8_MMA(1, 1, At, B1o); PG8_BAR; PG8_SCHED; } while (0)
#define PG8_PAIR_FIRST() do { \
              PG8_LDB(B0, 0, 0); PG8_LDB(B1e, 0, 1); PG8_SCHED; PG8_LDA(At, 0, 0); PG8_STAGE(PG8_SA(1, 1), a1 + hstepA, voffA); \
            PG8_WAIT_VX(6); PG8_WAIT_L(0); PG8_BAR; PG8_MMA(0, 0, At, B0); PG8_MMA(0, 1, At, B1e); PG8_BAR; PG8_SCHED; \
              PG8_LDA(At, 0, 1); PG8_LDB(B1o, 1, 1); PG8_STAGE(PG8_SB(0, 1), b2 + hstepB, voffB); PG8_STAGE(PG8_SB(0, 0), b2, voffB); PG8_STAGE(PG8_SA(0, 0), a2, voffA); \
            PG8_WAIT_VX(8); PG8_WAIT_L(0); PG8_BAR; PG8_MMA(1, 0, At, B0); PG8_MMA(1, 1, At, B1e); PG8_BAR; PG8_SCHED; \
            PG8_PAIR_TAIL(); } while (0)
        {
            const int sx = sxn; (void)sx;
            const char* a1 = cA + kstep; const char* a2 = cA + 2 * kstep; const char* b2 = cB + 2 * kstep; const char* a3 = a2 + kstep; const char* b3 = b2 + kstep;
            PG8_PAIR_FIRST();
        }
        for (int t = 2; t < nt; t += 2) {
            const bool last = (t == nt - 2);
            const char* a1 = cA + (size_t)(t + 1) * kstep;
            const char* a2 = last ? nA : cA + (size_t)(t + 2) * kstep; const char* b2 = last ? nB : cB + (size_t)(t + 2) * kstep;
            const char* a3 = a2 + kstep; const char* b3 = b2 + kstep;
            if (last) E.prefetch(lds, cur, wid, lane_id());
            PG8_PAIR();
        }
#undef PG8_PAIR
#undef PG8_PAIR_TAIL
#undef PG8_PAIR_FIRST
        if (wr == 0) PG8_BAR;
        { const int l2 = lane_id(); E(acc, cur, wr, wc, l2 & 15, l2 >> 4); }
        if (!has_next) break;
        if constexpr (Epi::SX > 0) sxn = E.nstore(cur);
        if (!E.keep(cur)) {
#pragma unroll
            for (int a = 0; a < 2; ++a)
#pragma unroll
                for (int b = 0; b < 2; ++b)
#pragma unroll
                    for (int m = 0; m < 4; ++m)
#pragma unroll
                        for (int n = 0; n < 2; ++n) acc[a][b][m][n] = (f32x4){0.f, 0.f, 0.f, 0.f};
        }
        cur = nxt; cA = nA; cB = nB; ++ui;
        if (wr == 1) PG8_BAR;
    }
    PG8_WAIT_V(0);
    PG8_BAR;
#undef PG8_SA
#undef PG8_SB
#undef PG8_STAGE
#undef PG8_LDA
#undef PG8_LDB
#undef PG8_MMA
#undef PG8_WAIT_V
#undef PG8_WAIT_L
#undef PG8_WAIT_VX
#undef PG8_BAR
#undef PG8_SCHED
}
}
using pg8::Unit;

struct SchedPlain {
    pg8::TileOrder T; const char* A; const char* Bt; size_t atile, btile;
    DI bool next(int i, Unit& u) const { u.part = 0; return T.tile(i, u.pm, u.pn); }
    DI const char* abase(const Unit& u) const { return A + (size_t)u.pm * atile; }
    DI const char* bbase(const Unit& u) const { return Bt + (size_t)u.pn * btile; }
};
struct SchedPair {
    pg8::TileOrder T; const char* A0; const char* A1; const char* B0; const char* B1; size_t atile, btile;
    DI bool next(int i, Unit& u) const { u.part = i & 1; return T.tile(i >> 1, u.pm, u.pn); }
    DI const char* abase(const Unit& u) const { return (u.part ? A1 : A0) + (size_t)u.pm * atile; }
    DI const char* bbase(const Unit& u) const { return (u.part ? B1 : B0) + (size_t)u.pn * btile; }
};
struct SchedUp {
    pg8::TileOrder T; const char* A; const char* Bt; size_t btile;
    DI bool next(int i, Unit& u) const { u.part = 0; return T.tile(i, u.pm, u.pn); }
    DI const char* abase(const Unit& u) const { const int b = u.pm / P4_TPS, j = u.pm % P4_TPS; return A + ((long)b * SEQ + 252 * j - 2) * (long)(DM * 2); }
    DI const char* bbase(const Unit& u) const { return Bt + (size_t)u.pn * btile; }
};

DI size_t gate_block(int pm, int ct, int wr, int wc) { return ((size_t)(((pm * 8 + ct) * 2 + wr) * 4 + wc)) * 4096; }
DI void gate_store(const f32x4 (&acc)[2][2][4][2], unsigned char* ga_blk, unsigned char* gb_blk, unsigned lo16) {
#pragma unroll
    for (int k = 0; k < 4; ++k) {
        u32x4 wa = (u32x4){0u, 0u, 0u, 0u}, wb = wa;
#pragma unroll
        for (int r = 0; r < 2; ++r) { const int ai = k >> 1, m = 2 * (k & 1) + r;
#pragma unroll
            for (int n = 0; n < 2; ++n)
                { unsigned ta[4], tb[4];
#pragma unroll
                    for (int e = 0; e < 4; ++e) { ta[e] = __builtin_bit_cast(unsigned, __builtin_fmaf(sig2(acc[ai][0][m][n][e]), 255.0f, 12582912.0f)); tb[e] = __builtin_bit_cast(unsigned, __builtin_fmaf(sig2(acc[ai][1][m][n][e]), 255.0f, 12582912.0f)); }
                    wa[2 * r + n] = __builtin_amdgcn_perm(__builtin_amdgcn_perm(ta[3], ta[2], 0x0c0c0400u), __builtin_amdgcn_perm(ta[1], ta[0], 0x0c0c0400u), 0x05040100u);
                    wb[2 * r + n] = __builtin_amdgcn_perm(__builtin_amdgcn_perm(tb[3], tb[2], 0x0c0c0400u), __builtin_amdgcn_perm(tb[1], tb[0], 0x0c0c0400u), 0x05040100u); } }
        *(u32x4*)(ga_blk + k * 1024 + lo16) = wa;
        *(u32x4*)(gb_blk + k * 1024 + lo16) = wb; }
}
DI void stg_put8(LAS char* stg, unsigned off, u32x2 w) { *(LAS u32x2*)(stg + off) = w; }
template <int SWZ> DI void stg_copy4k(LAS char* stg, char* g0, char* g1, unsigned lo16) {
    asm volatile("s_waitcnt lgkmcnt(0)" ::: "memory");
    const unsigned l0 = SWZ == 0 ? lo16 : (SWZ == 1 ? lo16 ^ (((lo16 >> 9) & 1u) << 4) : lo16 ^ (((lo16 >> 7) & 3u) << 4));
    constexpr unsigned x1 = SWZ == 0 ? 16u : (SWZ == 1 ? 32u : 0u), x2 = SWZ == 0 ? 32u : (SWZ == 1 ? 64u : 0u);
    const u32x4 a = *(const LAS u32x4*)(stg + l0), b = *(const LAS u32x4*)(stg + 1024 + (l0 ^ x1)), c = *(const LAS u32x4*)(stg + 2048 + (l0 ^ x2)), d = *(const LAS u32x4*)(stg + 3072 + (l0 ^ x1 ^ x2));
    *(u32x4*)(g0 + lo16) = a; *(u32x4*)(g0 + 1024 + lo16) = b; *(u32x4*)(g1 + lo16) = c; *(u32x4*)(g1 + 1024 + lo16) = d;
    asm volatile("s_waitcnt lgkmcnt(0)" ::: "memory");
}
DI void headnorm_store(const f32x4 (&acc)[2][2][4][2], int c4, int q4, int fq, int goff, float osc, LAS char* stg, char* g_c0, unsigned lo16) {
    const LAS float* gw = (const LAS float*)(stg + goff);
    const f32x4 g00 = *(const LAS f32x4*)(gw + 8 * fq), g01 = *(const LAS f32x4*)(gw + 8 * fq + 4), g10 = *(const LAS f32x4*)(gw + 32 + 8 * fq), g11 = *(const LAS f32x4*)(gw + 32 + 8 * fq + 4);
    asm volatile("s_waitcnt lgkmcnt(0)" ::: "memory");
    u32x4 pa[8], pb[8];
#pragma unroll
    for (int ai = 0; ai < 2; ++ai)
#pragma unroll
        for (int m = 0; m < 4; ++m) {
            f32x4 a0 = acc[ai][0][m][0], a1 = acc[ai][0][m][1], b0 = acc[ai][1][m][0], b1 = acc[ai][1][m][1];
            float ss = 0.f;
#pragma unroll
            for (int e = 0; e < 4; ++e) ss += a0[e] * a0[e] + a1[e] * a1[e] + b0[e] * b0[e] + b1[e] * b1[e];
            ss = xor32_sum(xor16_sum(ss));
            const float sc = __builtin_amdgcn_rsqf(ss * (1.0f / 64.0f) + EPS) * osc;
            pa[4 * ai + m] = pack8(a0 * sc * g00, a1 * sc * g01); pb[4 * ai + m] = pack8(b0 * sc * g10, b1 * sc * g11); }
    const unsigned loc = (((unsigned)(fq >> 1) * 512u + (8u * q4 + 32u * (fq & 1)) * 8u) * 2u) ^ ((unsigned)q4 << 4);
#pragma unroll
    for (int r = 0; r < 4; ++r) {
        if (c4 == r) {
#pragma unroll
            for (int j8 = 0; j8 < 8; ++j8) { const unsigned a_ = (loc ^ ((unsigned)(j8 & 3) << 4)) + (unsigned)(j8 >> 2) * 64u; *(LAS u32x4*)(stg + a_) = pa[j8]; *(LAS u32x4*)(stg + a_ + 2048) = pb[j8]; } }
        char* g = g_c0 + (size_t)r * 4096;
        stg_copy4k<2>(stg, g, g + 2048, lo16);
    }
}
template <int MODE> DI void tpiece_store(const f32x4 (&acc)[2][2][4][2], int bj, int c4, int q4, int fq, LAS char* stg, char* g_c0, size_t cstride, unsigned lo16) {
    const unsigned loc = (MODE == 1 ? (((unsigned)q4 * 256u + 8u * fq * 4u) * 2u) ^ ((unsigned)q4 << 4) ^ ((unsigned)(c4 & 1) << 6)
                                    : (((unsigned)(q4 >> 1) * 512u + 8u * fq * 8u + 4u * (q4 & 1)) * 2u) ^ ((unsigned)(q4 >> 1) << 4) ^ ((unsigned)(c4 & 1) << 5)) + (unsigned)(c4 & 1) * 2048u;
    u32x2 w[2][4][2];
#pragma unroll
    for (int n = 0; n < 2; ++n)
#pragma unroll
        for (int e = 0; e < 4; ++e)
#pragma unroll
            for (int ai = 0; ai < 2; ++ai) { float v0 = acc[ai][bj][0][n][e], v1 = acc[ai][bj][1][n][e], v2 = acc[ai][bj][2][n][e], v3 = acc[ai][bj][3][n][e];
                if (MODE == 1) { v0 = v0 * NLN2 * sig2(v0); v1 = v1 * NLN2 * sig2(v1); v2 = v2 * NLN2 * sig2(v2); v3 = v3 * NLN2 * sig2(v3); }
                w[n][e][ai].x = cvt_pk_bf16(v0, v1); w[n][e][ai].y = cvt_pk_bf16(v2, v3); }
#pragma unroll
    for (int r2 = 0; r2 < 2; ++r2) {
        if ((c4 >> 1) == r2) {
#pragma unroll
            for (int n = 0; n < 2; ++n)
#pragma unroll
                for (int e = 0; e < 4; ++e) {
                    const unsigned b_ = MODE == 1 ? (loc ^ ((unsigned)(2 * n + (e >> 1)) << 4)) + (unsigned)(e & 1) * 8u : (loc ^ ((unsigned)e << 4)) + (unsigned)n * 64u;
#pragma unroll
                    for (int ai = 0; ai < 2; ++ai) stg_put8(stg, b_ + (unsigned)ai * (MODE == 1 ? 256u : 512u), w[n][e][ai]); } }
        stg_copy4k<MODE>(stg, g_c0 + (size_t)(2 * r2) * cstride, g_c0 + (size_t)(2 * r2 + 1) * cstride, lo16);
    }
}
DI void qf_store(const f32x4 (&acc)[2][2][4][2], int pm, int head, int wr, int wc, int fr, int fq, const float* lb, bf16_t* KA, bf16_t* QA, float* EREF, bf16_t* KBT, float* DEC, LAS char* stg) {
    const int b = pm >> 5, cw = ((pm & 31) << 3) + 4 * wr, c4 = fr >> 2, q4 = fr & 3;
    const unsigned cbw = (unsigned)((b * 4 + head) * 256 + cw), cb = cbw + c4;
    const int dk0 = 32 * wc + 8 * fq;
    const unsigned lane = (unsigned)(fq * 16 + fr), lo16 = lane * 16u, lh = lane >> 5, ll16 = (lane & 31u) * 16u;
    const f32x4 l0 = *(const LAS f32x4*)(stg + dk0 * 4), l1 = *(const LAS f32x4*)(stg + dk0 * 4 + 16);
    asm volatile("s_waitcnt lgkmcnt(0)" ::: "memory");
    const unsigned hb = (dk0 >> 3) & 1;
    const unsigned kq_l = ((((unsigned)(fq >> 1) * 512u + 4u * hb + 8u * q4 * 8u) * 2u) ^ ((unsigned)q4 << 4) ^ ((unsigned)(c4 & 1) << 6)) + (unsigned)(c4 & 1) * 2048u;
    const unsigned kb_l = ((((unsigned)(q4 >> 1) * 512u + 8u * fq * 8u + 4u * (q4 & 1)) * 2u) ^ ((unsigned)(q4 >> 1) << 4) ^ ((unsigned)(c4 & 1) << 5)) + (unsigned)(c4 & 1) * 2048u;
    u32x2 pkb[8][2];
#pragma unroll
    for (int n = 0; n < 2; ++n) {
        unsigned pqa[8][2], pka[8][2];
#pragma unroll
        for (int ep = 0; ep < 2; ++ep) {
            float qa[2][8], ka[2][8];
#pragma unroll
            for (int eo = 0; eo < 2; ++eo) { const int e = 2 * ep + eo; const float lbv = n ? l1[e] : l0[e];
                float qh[8], kk[8], cum[8];
                float run = 1.f;
#pragma unroll
                for (int j8 = 0; j8 < 8; ++j8) { const int ai = j8 >> 2, m = j8 & 3;
                    const float f = lbv + (1.0f - lbv) * sig2(acc[ai][1][m][n][e]);
                    qh[j8] = acc[ai][0][m][n][e] * (NLN2 * 0.08838834764831845f) * sig2(acc[ai][0][m][n][e]); kk[j8] = 1.0f - f;
                    run *= f; cum[j8] = run; }
                const float t1 = dppf<0x90>(run), t2 = dppf<0x44>(run), t3 = dppf<0x24>(run);
                const float excl = (q4 >= 1 ? t1 : 1.f) * (q4 >= 2 ? t2 : 1.f) * (q4 >= 3 ? t3 : 1.f);
                const float c7 = excl * run;
                const float ref = dppf<0x55>(c7), cend = dppf<0xFF>(c7);
                float kb[8];
                const float rref = __builtin_amdgcn_rcpf(ref), eref = ref, ecr = cend * rref;
#pragma unroll
                for (int j8 = 0; j8 < 8; ++j8) { const float e1 = (excl * cum[j8]) * rref, r1 = __builtin_amdgcn_rcpf(e1);
                    qa[eo][j8] = qh[j8] * e1; ka[eo][j8] = kk[j8] * r1; kb[j8] = ka[eo][j8] * ecr; }
                const unsigned dk = dk0 + 4 * n + e;
                if (q4 == 3) { DEC[cb * 128u + dk] = cend; EREF[cb * 128u + dk] = eref; }
#pragma unroll
                for (int ai = 0; ai < 2; ++ai) { pkb[4 * n + e][ai].x = cvt_pk_bf16(kb[4 * ai], kb[4 * ai + 1]); pkb[4 * n + e][ai].y = cvt_pk_bf16(kb[4 * ai + 2], kb[4 * ai + 3]); }
            }
#pragma unroll
            for (int j8 = 0; j8 < 8; ++j8) { pqa[j8][ep] = cvt_pk_bf16(qa[0][j8], qa[1][j8]); pka[j8][ep] = cvt_pk_bf16(ka[0][j8], ka[1][j8]); }
        }
#pragma unroll
        for (int arr = 0; arr < 2; ++arr) { char* gb = (char*)(arr ? QA : KA);
#pragma unroll
            for (int r2 = 0; r2 < 2; ++r2) {
                if ((c4 >> 1) == r2) {
#pragma unroll
                    for (int j8 = 0; j8 < 8; ++j8) stg_put8(stg, (kq_l ^ ((unsigned)j8 << 4)) + (unsigned)n * 512u, arr ? (u32x2){pqa[j8][0], pqa[j8][1]} : (u32x2){pka[j8][0], pka[j8][1]}); }
                asm volatile("s_waitcnt lgkmcnt(0)" ::: "memory");
#pragma unroll
                for (int k = 0; k < 2; ++k) { const unsigned run = 2u * k + lh, img = run >> 1, frag = run & 1u;
                    const u32x4 v = *(const LAS u32x4*)(stg + img * 2048u + frag * 1024u + (unsigned)n * 512u + (ll16 ^ (((ll16 >> 7) & 3u) << 4) ^ (img << 6)));
                    *(u32x4*)(gb + ((size_t)(cbw + 2 * r2 + img) * 4096 + (2 * wc + frag) * 512) * 2 + n * 512 + ll16) = v; }
                asm volatile("s_waitcnt lgkmcnt(0)" ::: "memory");
            } }
    }
#pragma unroll
    for (int r2 = 0; r2 < 2; ++r2) {
        if ((c4 >> 1) == r2) {
#pragma unroll
            for (int col = 0; col < 8; ++col)
#pragma unroll
                for (int ai = 0; ai < 2; ++ai) stg_put8(stg, (kb_l ^ ((unsigned)(col & 3) << 4)) + (unsigned)(col >> 2) * 64u + (unsigned)ai * 512u, pkb[col][ai]); }
        stg_copy4k<0>(stg, (char*)KBT + ((size_t)(cbw + 2 * r2) * 4096 + 2 * wc * 512) * 2, (char*)KBT + ((size_t)(cbw + 2 * r2 + 1) * 4096 + 2 * wc * 512) * 2, lo16);
    }
}
struct EpiIn {
    static constexpr bool PERM = true;
    DI void prefetch(LAS unsigned char* l, const Unit& u, int wid, int lane) const {
        const float* lbp = (const float*)(ws + WS_LB) + 128 * (u.pn < 4 ? u.pn : 3);
        const float* src = lane < 32 ? lbp + lane * 4 : (lane < 48 ? qg + (lane - 32) * 4 : kg + (lane - 48) * 4);
        __builtin_amdgcn_global_load_lds((const unsigned*)src, (LAS unsigned*)(l + STG_OFF + wid * 4096), 16, 0, 0);
    }
    const float* qg; const float* kg;
    unsigned char* ws; LAS unsigned char* lds; int wave;
    DI bool keep(const Unit&) const { return false; }
    static constexpr int SX = 8;
    DI int nstore(const Unit&) const { return 1; }
    DI void operator()(f32x4 (&acc)[2][2][4][2], const Unit& u, int wr, int wc, int fr, int fq) const {
        bf16_t* KA = (bf16_t*)(ws + WS_KA); bf16_t* QA = (bf16_t*)(ws + WS_QA); float* EREF = (float*)(ws + WS_EREF); bf16_t* KBT = (bf16_t*)(ws + WS_KBT); bf16_t* VT = (bf16_t*)(ws + WS_VT);
        bf16_t* G = (bf16_t*)(ws + WS_G); bf16_t* AQ = (bf16_t*)(ws + WS_AQ); bf16_t* AK = (bf16_t*)(ws + WS_AK); bf16_t* AV = (bf16_t*)(ws + WS_AV); bf16_t* GA = (bf16_t*)(ws + WS_GA); bf16_t* GB = (bf16_t*)(ws + WS_GB);
        float* DEC = (float*)(ws + WS_DEC); const float* lb = (const float*)(ws + WS_LB);
        LAS char* stg = (LAS char*)(lds + STG_OFF + wave * 4096);
        const int rowb = u.pm * 256 + 128 * wr + 8 * fr;
        const int c8 = 32 * wc + 8 * fq;
        const int pn = u.pn;
        const int b = u.pm >> 5, cw = ((u.pm & 31) << 3) + 4 * wr, c4 = fr >> 2, q4 = fr & 3;
        const unsigned lo16 = (unsigned)(fq * 16 + fr) * 16u;
        if (pn < 4) {
            qf_store(acc, u.pm, pn, wr, wc, fr, fq, lb, KA, QA, EREF, KBT, DEC, stg);
        } else if (pn < 6) {
#pragma unroll
            for (int bj = 0; bj < 2; ++bj)
                tpiece_store<0>(acc, bj, c4, q4, fq, stg, (char*)VT + (((size_t)(b * 4 + 2 * (pn - 4) + bj) * 256 + cw) * 4096 + wc * 1024) * 2, (size_t)8192, lo16);
        } else if (pn < 8) {
#pragma unroll
            for (int bj = 0; bj < 2; ++bj)
                tpiece_store<1>(acc, bj, c4, q4, fq, stg, (char*)G + (((size_t)(b * 4 + 2 * (pn - 6) + bj) * 256 + cw) * 4096 + wc * 1024) * 2, (size_t)8192, lo16);
        } else if (pn < 10) {
            headnorm_store(acc, c4, q4, fq, 512, QSCALE, stg, (char*)AQ + ((size_t)(b * 8 + 4 * (pn - 8) + wc) * 256 + cw) * 4096, lo16);
        } else if (pn == 10) {
            if (wc < 2) headnorm_store(acc, c4, q4, fq, 768, 1.0f, stg, (char*)AK + ((size_t)(b * 2 + wc) * 256 + cw) * 4096, lo16);
            else {
#pragma unroll
                for (int bj = 0; bj < 2; ++bj)
                    tpiece_store<0>(acc, bj, c4, q4, fq, stg, (char*)AV + (((size_t)(b * 2 + wc - 2) * 256 + cw) * 2048 + bj * 1024) * 2, (size_t)4096, lo16); }
        } else {
            gate_store(acc, (unsigned char*)GA + gate_block(u.pm, pn - 11, wr, wc), (unsigned char*)GB + gate_block(u.pm, pn - 11, wr, wc), lo16);
        }
    }
};


struct EpiBranch {
    static constexpr bool PERM = true;
    DI void prefetch(LAS unsigned char*, const Unit&, int, int) const {}
    const unsigned char* GA8; const unsigned char* GB8; bf16_t* MIXED;
    DI bool keep(const Unit& u) const { return u.part == 0; }
    static constexpr int SX = 16;
    DI int nstore(const Unit& u) const { return u.part; }
    DI void operator()(f32x4 (&acc)[2][2][4][2], const Unit& u, int wr, int wc, int fr, int fq) const {
        const int rowb = u.pm * 256 + 128 * wr + 8 * fr, colb = u.pn * 256 + 32 * wc + 8 * fq;
        const unsigned lo16 = (unsigned)(fq * 16 + fr) * 16u;
        u32x4 gb[2][4], ga[2][4];
#pragma unroll
        for (int bj = 0; bj < 2; ++bj) { const size_t blk = gate_block(u.pm, 2 * u.pn + bj, wr, wc);
#pragma unroll
            for (int k = 0; k < 4; ++k) { gb[bj][k] = *(const u32x4*)(GB8 + blk + k * 1024 + lo16); if (u.part == 0) ga[bj][k] = *(const u32x4*)(GA8 + blk + k * 1024 + lo16); } }
        __builtin_amdgcn_sched_barrier(0);
#pragma unroll
        for (int ai = 0; ai < 2; ++ai)
#pragma unroll
            for (int m = 0; m < 4; ++m) { const size_t off = (size_t)(rowb + 4 * ai + m) * DM + colb; const int k = 2 * ai + (m >> 1), r = m & 1;
#pragma unroll
                for (int bj = 0; bj < 2; ++bj) {
                    f32x4 g0, g1;
                    const unsigned b0 = gb[bj][k][2 * r], b1 = gb[bj][k][2 * r + 1];
                    g0 = (f32x4){(float)(b0 & 255u), (float)((b0 >> 8) & 255u), (float)((b0 >> 16) & 255u), (float)(b0 >> 24)};
                    g1 = (f32x4){(float)(b1 & 255u), (float)((b1 >> 8) & 255u), (float)((b1 >> 16) & 255u), (float)(b1 >> 24)};
#pragma unroll
                    for (int e = 0; e < 4; ++e) { g0[e] = fmaxf(g0[e], 0.5f); g1[e] = fmaxf(g1[e], 0.5f); }
                    if (u.part == 0) {
                        const unsigned a0 = ga[bj][k][2 * r], a1 = ga[bj][k][2 * r + 1];
                        const f32x4 h0 = (f32x4){(float)(a0 & 255u), (float)((a0 >> 8) & 255u), (float)((a0 >> 16) & 255u), (float)(a0 >> 24)};
                        const f32x4 h1 = (f32x4){(float)(a1 & 255u), (float)((a1 >> 8) & 255u), (float)((a1 >> 16) & 255u), (float)(a1 >> 24)};
#pragma unroll
                        for (int e = 0; e < 4; ++e) { acc[ai][bj][m][0][e] *= h0[e] * __builtin_amdgcn_rcpf(g0[e]); acc[ai][bj][m][1][e] *= h1[e] * __builtin_amdgcn_rcpf(g1[e]); }
                    } else *(u32x4*)(MIXED + off + 128 * bj) = pack8(acc[ai][bj][m][0] * g0 * (1.0f / 255.0f), acc[ai][bj][m][1] * g1 * (1.0f / 255.0f));
                } }
    }
};

struct EpiOut {
    static constexpr bool PERM = true;
    DI void prefetch(LAS unsigned char*, const Unit&, int, int) const {}
    const bf16_t* XN; const float* rms; bf16_t* X1B; float* sumsq;
    DI bool keep(const Unit&) const { return false; }
    static constexpr int SX = 0;
    DI int nstore(const Unit&) const { return 1; }
    DI void operator()(f32x4 (&acc)[2][2][4][2], const Unit& u, int wr, int wc, int fr, int fq) const {
        const int rowb = u.pm * 256 + 64 * wr + fr, colb = u.pn * 256 + 32 * wc + 8 * fq;
        u32x4 xr[2][4][2]; float rr[2][4];
#pragma unroll
        for (int ai = 0; ai < 2; ++ai)
#pragma unroll
            for (int m = 0; m < 4; ++m) { const int row = rowb + 128 * ai + 16 * m; rr[ai][m] = rms[row];
#pragma unroll
                for (int bj = 0; bj < 2; ++bj) xr[ai][m][bj] = *(const u32x4*)(XN + (size_t)row * DM + colb + 128 * bj); }
        __builtin_amdgcn_sched_barrier(0);
#pragma unroll
        for (int ai = 0; ai < 2; ++ai)
#pragma unroll
            for (int m = 0; m < 4; ++m) { const int row = rowb + 128 * ai + 16 * m; const size_t off = (size_t)row * DM + colb; float ss = 0.f;
#pragma unroll
                for (int bj = 0; bj < 2; ++bj) {
                    f32x4 x0, x1; unpack8(xr[ai][m][bj], x0, x1);
                    const f32x4 a = acc[ai][bj][m][0] + x0 * rr[ai][m], b = acc[ai][bj][m][1] + x1 * rr[ai][m];
                    *(u32x4*)(X1B + off + 128 * bj) = pack8(a, b);
#pragma unroll
                    for (int e = 0; e < 4; ++e) ss += a[e] * a[e] + b[e] * b[e]; }
                ss = xor32_sum(xor16_sum(ss));
                if (fq == 0) atomicAdd(sumsq + row, ss); }
    }
};

struct EpiUp {
    static constexpr bool PERM = true;
    const float* sumsq; const float* cw; const float* cb; bf16_t* ACT; LAS unsigned char* lds;
    DI bool keep(const Unit&) const { return false; }
    static constexpr int SX = 8;
    DI int nstore(const Unit&) const { return 1; }
    DI void prefetch(LAS unsigned char* l, const Unit& u, int wid, int lane) const {
        LAS unsigned char* st = l + STG_OFF;
        if (wid == 0) { const int b = u.pm / P4_TPS, j = u.pm % P4_TPS;
#pragma unroll
            for (int q = 0; q < 4; ++q) { int tau = 252 * j - 2 + q * 64 + lane; tau = tau < 0 ? 0 : (tau > SEQ - 1 ? SEQ - 1 : tau);
                __builtin_amdgcn_global_load_lds((const unsigned*)(sumsq + (size_t)b * SEQ + tau), (LAS unsigned*)(st + q * 256), 4, 0, 0); }
        } else if (wid == 1) {
            __builtin_amdgcn_global_load_lds((const unsigned*)(cw + (size_t)(lane >> 5) * DFF + 128 * u.pn + (lane & 31) * 4), (LAS unsigned*)(st + 1024), 16, 0, 0);
        } else if (wid == 2) {
            __builtin_amdgcn_global_load_lds((const unsigned*)((lane < 32 ? cw + 2 * DFF : cb) + 128 * u.pn + (lane & 31) * 4), (LAS unsigned*)(st + 2048), 16, 0, 0);
        }
    }
    DI void operator()(f32x4 (&acc)[2][2][4][2], const Unit& u, int wr, int wc, int fr, int fq) const {
        const int b = u.pm / P4_TPS, j = u.pm % P4_TPS;
        const int tau0 = 252 * j + 126 * wr - 2 + 8 * fr;
        const int col = 128 * u.pn + 32 * wc + 8 * fq;
        const LAS unsigned char* st = lds + STG_OFF;
        const unsigned dumpoff = (unsigned)(352u * 1024u * 1024u) + (unsigned)(fq * 16 + fr) * 16u;
        float rs[8];
#pragma unroll
        for (int k = 0; k < 8; ++k) { const int tau = tau0 + k; const bool ok = tau >= 0 && tau < SEQ; const float s = *(const LAS float*)(st + (126 * wr + 8 * fr + k) * 4);
            rs[k] = ok ? __builtin_amdgcn_rsqf(s * (1.0f / DM) + EPS) : 0.f; }
        f32x4 w0[2], w1[2], w2[2], bb[2];
#pragma unroll
        for (int n = 0; n < 2; ++n) { const int lc = (32 * wc + 8 * fq + 4 * n) * 4; w0[n] = *(const LAS f32x4*)(st + 1024 + lc); w1[n] = *(const LAS f32x4*)(st + 1536 + lc); w2[n] = *(const LAS f32x4*)(st + 2048 + lc); bb[n] = *(const LAS f32x4*)(st + 2560 + lc); }
        f32x4 g[8][2];
#pragma unroll
        for (int ai = 0; ai < 2; ++ai)
#pragma unroll
            for (int m = 0; m < 4; ++m)
#pragma unroll
                for (int n = 0; n < 2; ++n) { const int k = 4 * ai + m; f32x4 v = acc[ai][0][m][n] * rs[k]; if (rs[k] == 0.f) v = (f32x4){0.f, 0.f, 0.f, 0.f}; g[k][n] = v; }
        f32x4 gm1[2], gm2[2];
#pragma unroll
        for (int n = 0; n < 2; ++n)
#pragma unroll
            for (int e = 0; e < 4; ++e) { gm1[n][e] = dppf<0x111>(g[7][n][e]); gm2[n][e] = dppf<0x111>(g[6][n][e]); }
#pragma unroll
        for (int k = 0; k < 8; ++k) {
            const int tau = tau0 + k; const int loc = 8 * fr + k;
            const int ai = k >> 2, m = k & 3;
            u32x4 w;
            f32x4 o[2];
#pragma unroll
            for (int n = 0; n < 2; ++n) {
                const f32x4 p1 = (k >= 1) ? g[k >= 1 ? k - 1 : 0][n] : gm1[n];
                const f32x4 p2 = (k >= 2) ? g[k >= 2 ? k - 2 : 0][n] : (k == 1 ? gm1[n] : gm2[n]);
                const f32x4 cv = bb[n] + w0[n] * p2 + w1[n] * p1 + w2[n] * g[k][n];
                const f32x4 vv = acc[ai][1][m][n] * rs[k];
                const f32x2 ga = gelu_pk((f32x2){cv[0], cv[1]}), gbv = gelu_pk((f32x2){cv[2], cv[3]});
                o[n] = (f32x4){ga.x * vv[0], ga.y * vv[1], gbv.x * vv[2], gbv.y * vv[3]};
            }
            w = pack8(o[0], o[1]);
            const bool ok = loc >= 2 && tau >= 0 && tau < SEQ;
            const unsigned off = ok ? ((unsigned)(b * SEQ + tau) * (unsigned)DFF + (unsigned)col) * 2u : dumpoff;
            *(u32x4*)((char*)ACT + off) = w;
        }
    }
};

struct EpiDown {
    static constexpr bool PERM = true;
    DI void prefetch(LAS unsigned char*, const Unit&, int, int) const {}
    const bf16_t* X1B; float* out;
    DI bool keep(const Unit&) const { return false; }
    static constexpr int SX = 32;
    DI int nstore(const Unit&) const { return 1; }
    DI void operator()(f32x4 (&acc)[2][2][4][2], const Unit& u, int wr, int wc, int fr, int fq) const {
        const int rowb = u.pm * 256 + 64 * wr + fr, colb = u.pn * 256 + 32 * wc + 8 * fq;
        u32x4 rsd[2][4][2];
#pragma unroll
        for (int ai = 0; ai < 2; ++ai)
#pragma unroll
            for (int m = 0; m < 4; ++m)
#pragma unroll
                for (int bj = 0; bj < 2; ++bj) rsd[ai][m][bj] = *(const u32x4*)(X1B + (size_t)(rowb + 128 * ai + 16 * m) * DM + colb + 128 * bj);
        __builtin_amdgcn_sched_barrier(0);
#pragma unroll
        for (int ai = 0; ai < 2; ++ai)
#pragma unroll
            for (int m = 0; m < 4; ++m) { const size_t off = (size_t)(rowb + 128 * ai + 16 * m) * DM + colb;
#pragma unroll
                for (int bj = 0; bj < 2; ++bj) {
                    f32x4 r0, r1; unpack8(rsd[ai][m][bj], r0, r1);
                    *(f32x4*)(out + off + 128 * bj) = acc[ai][bj][m][0] + r0; *(f32x4*)(out + off + 128 * bj + 4) = acc[ai][bj][m][1] + r1; } }
    }
};

DI int colmap_in(int n) {
    const int t = n >> 8, j = n & 255;
    if (t < 4) return j < 128 ? HG_Q0 + 128 * t + j : HG_F0 + 128 * t + (j - 128);
    if (t < 8) return HG_I0 + 256 * (t - 4) + j;
    const int bj = j >> 7, wc = (j >> 5) & 3, e = j & 31;
    if (t < 10) return AT_Q0 + 64 * (4 * (t - 8) + wc) + 32 * bj + e;
    if (t == 10) return wc < 2 ? AT_K0 + 64 * wc + 32 * bj + e : AT_V0 + 64 * (wc - 2) + 32 * bj + e;
    return j < 128 ? GATE_A0 + 128 * (t - 11) + j : GATE_B0 + 128 * (t - 11) + (j - 128);
}
DI int colmap_up(int n) { const int t = n >> 8, j = n & 255; return j < 128 ? 128 * t + j : DFF + 128 * t + (j - 128); }
DI void transpose_item(const float* W, int Kd, int Nsrc, int n0s, bf16_t* WT, int n0d, int k0, const float* gk, LAS float* scr, int lane, float cs = 1.0f) {
#pragma unroll 8
    for (int i = 0; i < 32; ++i) { const int kk = 2 * i + (lane >> 5); float v = W[(size_t)(k0 + kk) * Nsrc + n0s + (lane & 31)]; if (gk) v *= gk[k0 + kk] * cs; scr[kk * 33 + (lane & 31)] = v; }
    asm volatile("s_waitcnt lgkmcnt(0)" ::: "memory");
    const int c = lane & 7;
#pragma unroll
    for (int j = 0; j < 4; ++j) { const int n = (lane >> 3) + 8 * j; const LAS float* s = scr + (8 * c) * 33 + n;
        u32x4 o; o.x = pk2(s[0 * 33], s[1 * 33]); o.y = pk2(s[2 * 33], s[3 * 33]); o.z = pk2(s[4 * 33], s[5 * 33]); o.w = pk2(s[6 * 33], s[7 * 33]);
        *(u32x4*)(WT + (size_t)(n0d + n) * Kd + k0 + 8 * c) = o; }
    asm volatile("s_waitcnt lgkmcnt(0)" ::: "memory");
}


DI f32x16 mfma32(bf16x8 a, bf16x8 b, f32x16 c) { return __builtin_amdgcn_mfma_f32_32x32x16_bf16(a, b, c, 0, 0, 0); }
DI bf16x8 ldfrag(const bf16_t* ubase, int fidx, unsigned lo16) { return *(const bf16x8*)((const char*)(ubase + fidx * 512) + lo16); }
DI bf16x8 packstep(const f32x16& x, int s) { u32x4 p; p.x = cvt_pk_bf16(x[8 * s], x[8 * s + 1]); p.y = cvt_pk_bf16(x[8 * s + 2], x[8 * s + 3]); p.z = cvt_pk_bf16(x[8 * s + 4], x[8 * s + 5]); p.w = cvt_pk_bf16(x[8 * s + 6], x[8 * s + 7]); return __builtin_bit_cast(bf16x8, p); }
DI int crow(int i, int h) { return (i & 3) + 8 * (i >> 2) + 4 * h; }
#define SB0() __builtin_amdgcn_sched_barrier(0)
DI void stage_vec(LAS float* dst, const float* SRC, int gi, int vs, int lane) {
    const size_t cb0 = (size_t)(gi >> 4) * 256 + (gi & 15) * CPS;
#pragma unroll
    for (int k = 0; k < 4; ++k) { const int c = 4 * vs + k; *(LAS f32x2*)(dst + c * 128 + 2 * lane) = *(const f32x2*)((const char*)(SRC + (cb0 + c) * 128) + (unsigned)lane * 8u); }
}
constexpr int PA_RING = 32768, PA_STAGE = 32768;
DI void scan_pass_a(int gi, int vs, int lane, LAS unsigned char* lds, LAS float* decl, const bf16_t* KBT, const bf16_t* VT, const float* DEC, float* SLOC, float* DSEG) {
    const int h = lane >> 5, bh = gi >> 4, g = gi & 15, grp = (int)((decl - (LAS float*)(lds + 4096)) >> 11);
    const unsigned lo16 = (unsigned)lane * 16u;
    f32x16 S[4];
#pragma unroll
    for (int kt = 0; kt < 4; ++kt)
#pragma unroll
        for (int i = 0; i < 16; ++i) S[kt][i] = 0.f;
    const size_t cb0 = (size_t)bh * 256 + g * CPS;
    LAS unsigned char* ring = lds + PA_RING + grp * 16384;
#define PA_ISSUE(c_) do { const int cc_ = (c_) < CPS ? (c_) : CPS - 1; LAS unsigned char* st_ = ring + ((c_) & 3) * PA_STAGE; \
        const char* kb_ = (const char*)(KBT + (cb0 + cc_) * 4096 + (2 * vs) * 512); const char* vb_ = (const char*)(VT + (cb0 + cc_) * 4096 + (2 * vs) * 512); \
        __builtin_amdgcn_global_load_lds((const unsigned*)(kb_ + lo16), (LAS unsigned*)(st_ + (2 * vs) * 1024), 16, 0, 0); \
        __builtin_amdgcn_global_load_lds((const unsigned*)(kb_ + 1024 + lo16), (LAS unsigned*)(st_ + (2 * vs + 1) * 1024), 16, 0, 0); \
        __builtin_amdgcn_global_load_lds((const unsigned*)(vb_ + lo16), (LAS unsigned*)(st_ + 8192 + (2 * vs) * 1024), 16, 0, 0); \
        __builtin_amdgcn_global_load_lds((const unsigned*)(vb_ + 1024 + lo16), (LAS unsigned*)(st_ + 8192 + (2 * vs + 1) * 1024), 16, 0, 0); } while (0)
    PA_ISSUE(0); PA_ISSUE(1); PA_ISSUE(2);
    for (int c = 0; c < CPS; ++c) {
        asm volatile("s_waitcnt vmcnt(8)" ::: "memory");
        __builtin_amdgcn_s_barrier();
        asm volatile("" ::: "memory");
        PA_ISSUE(c + 3);
        const LAS unsigned char* st = ring + (c & 3) * PA_STAGE;
        bf16x8 kf[8], vf[2];
#pragma unroll
        for (int f = 0; f < 8; ++f) kf[f] = *(const LAS bf16x8*)(st + f * 1024 + lo16);
        vf[0] = *(const LAS bf16x8*)(st + 8192 + (2 * vs) * 1024 + lo16); vf[1] = *(const LAS bf16x8*)(st + 8192 + (2 * vs + 1) * 1024 + lo16);
#pragma unroll
        for (int kt = 0; kt < 4; ++kt) {
            f32x4 d[4];
#pragma unroll
            for (int i4 = 0; i4 < 4; ++i4) d[i4] = *(const LAS f32x4*)(decl + c * 128 + 32 * kt + 8 * i4 + 4 * h);
#pragma unroll
            for (int i4 = 0; i4 < 4; ++i4)
#pragma unroll
                for (int e = 0; e < 4; ++e) S[kt][4 * i4 + e] *= d[i4][e];
            S[kt] = mfma32(kf[kt * 2], vf[0], S[kt]);
            S[kt] = mfma32(kf[kt * 2 + 1], vf[1], S[kt]); }
    }
    asm volatile("s_waitcnt vmcnt(0)" ::: "memory");
#undef PA_ISSUE
    float* sl = SLOC + (size_t)(gi * 4 + vs) * 4096;
#pragma unroll
    for (int kt = 0; kt < 4; ++kt)
#pragma unroll
        for (int i4 = 0; i4 < 4; ++i4) *(f32x4*)((char*)(sl + (kt * 4 + i4) * 256) + lo16) = (f32x4){S[kt][4 * i4], S[kt][4 * i4 + 1], S[kt][4 * i4 + 2], S[kt][4 * i4 + 3]};
    if (vs == 0) {
        f32x2 p = (f32x2){1.f, 1.f};
#pragma unroll 4
        for (int c = 0; c < CPS; ++c) p = p * *(const f32x2*)((const char*)(DEC + (cb0 + c) * 128) + (lo16 >> 1));
        *(f32x2*)((char*)(DSEG + (size_t)gi * 128) + (lo16 >> 1)) = p; }
}
DI void scan_pass_b(int gi, int vs, int wave, int lane, LAS float* xl, LAS float* decl, const bf16_t* KA, const bf16_t* QA, const bf16_t* KBT, const bf16_t* VT, const float* DEC,
                    const float* SLOC, const float* DSEG, const bf16_t* GF, const float* og, bf16_t* OA) {
    const int r = lane & 31, h = lane >> 5, bh = gi >> 4, g = gi & 15, b = bh >> 2, hh = bh & 3, grp = wave >> 2;
    const unsigned lo16 = (unsigned)lane * 16u, ho16 = (unsigned)h * 16u;
    f32x16 S[4];
#pragma unroll
    for (int kt = 0; kt < 4; ++kt)
#pragma unroll
        for (int i = 0; i < 16; ++i) S[kt][i] = 0.f;
    if (g > 0) {
        f32x4 P[4][4];
#pragma unroll
        for (int kt = 0; kt < 4; ++kt)
#pragma unroll
            for (int i4 = 0; i4 < 4; ++i4) P[kt][i4] = (f32x4){1.f, 1.f, 1.f, 1.f};
        for (int j = g - 1; j >= 0; --j) {
            const float* sl = SLOC + (size_t)((gi - g + j) * 4 + vs) * 4096; const float* ds = DSEG + (size_t)(gi - g + j) * 128;
            float pmx = 0.f;
#pragma unroll
            for (int kt = 0; kt < 4; ++kt) {
#pragma unroll
                for (int i4 = 0; i4 < 4; ++i4) { const f32x4 x = *(const f32x4*)((const char*)(sl + (kt * 4 + i4) * 256) + lo16); const f32x4 d = *(const f32x4*)((const char*)(ds + 32 * kt + 8 * i4) + ho16);
#pragma unroll
                    for (int e = 0; e < 4; ++e) { S[kt][4 * i4 + e] += P[kt][i4][e] * x[e]; P[kt][i4][e] *= d[e]; pmx = fmaxf(pmx, P[kt][i4][e]); } }
                SB0(); }
            if (__all(pmx == 0.f)) break;
        }
    }
    const float ogv = og[vs * 32 + r];
    const size_t cb0 = (size_t)bh * 256 + g * CPS;
    bf16x8 ka[8], qa[8], kb[8], v0, v1; u32x2 gq[4];
#pragma unroll
    for (int ks = 0; ks < 8; ++ks) { ka[ks] = ldfrag(KA + cb0 * 4096, ks, lo16); qa[ks] = ldfrag(QA + cb0 * 4096, ks, lo16); kb[ks] = ldfrag(KBT + cb0 * 4096, ks, lo16); }
    v0 = ldfrag(VT + cb0 * 4096, vs * 2, lo16); v1 = ldfrag(VT + cb0 * 4096, vs * 2 + 1, lo16);
#pragma unroll
    for (int i4 = 0; i4 < 4; ++i4) gq[i4] = *(const u32x2*)((const char*)(GF + cb0 * 4096 + vs * 1024 + i4 * 256) + (lo16 >> 1));
    for (int c = 0; c < CPS; ++c) {
        const size_t cn = cb0 + (c + 1 < CPS ? c + 1 : c);
        SB0();
        f32x16 X;
#pragma unroll
        for (int i = 0; i < 16; ++i) X[i] = 0.f;
#pragma unroll
        for (int ks = 0; ks < 8; ++ks) X = mfma32(ka[ks], qa[ks], X);
#pragma unroll
        for (int i = 0; i < 16; ++i) if (crow(i, h) > r) X[i] = 0.f;
        const bf16x8 px0 = packstep(X, 0), px1 = packstep(X, 1);
        SB0();
#pragma unroll
        for (int ks = 0; ks < 8; ++ks) ka[ks] = ldfrag(KA + cn * 4096, ks, lo16);
        SB0();
        f32x16 O;
#pragma unroll
        for (int i = 0; i < 16; ++i) O[i] = 0.f;
        O = mfma32(px0, v0, O); O = mfma32(px1, v1, O);
#pragma unroll
        for (int kt = 0; kt < 4; ++kt) {
            f32x16 Se;
#pragma unroll
            for (int i4 = 0; i4 < 4; ++i4) { const f32x4 er = *(const LAS f32x4*)(decl + 4096 + c * 128 + 32 * kt + 8 * i4 + 4 * h);
#pragma unroll
                for (int e = 0; e < 4; ++e) Se[4 * i4 + e] = S[kt][4 * i4 + e] * er[e]; }
            O = mfma32(qa[kt * 2], packstep(Se, 0), O); O = mfma32(qa[kt * 2 + 1], packstep(Se, 1), O); }
        SB0();
#pragma unroll
        for (int ks = 0; ks < 8; ++ks) qa[ks] = ldfrag(QA + cn * 4096, ks, lo16);
        SB0();
#pragma unroll
        for (int kt = 0; kt < 4; ++kt) {
            f32x4 d[4];
#pragma unroll
            for (int i4 = 0; i4 < 4; ++i4) d[i4] = *(const LAS f32x4*)(decl + c * 128 + 32 * kt + 8 * i4 + 4 * h);
#pragma unroll
            for (int i4 = 0; i4 < 4; ++i4)
#pragma unroll
                for (int e = 0; e < 4; ++e) S[kt][4 * i4 + e] *= d[i4][e];
            S[kt] = mfma32(kb[kt * 2], v0, S[kt]); S[kt] = mfma32(kb[kt * 2 + 1], v1, S[kt]); }
        SB0();
#pragma unroll
        for (int ks = 0; ks < 8; ++ks) kb[ks] = ldfrag(KBT + cn * 4096, ks, lo16);
        v0 = ldfrag(VT + cn * 4096, vs * 2, lo16); v1 = ldfrag(VT + cn * 4096, vs * 2 + 1, lo16);
        SB0();
        float ss[16];
        LAS float* xb = xl + (c & 1) * 256;
        {
#pragma unroll
        for (int i = 0; i < 16; ++i) ss[i] = O[i] * O[i];
        {   const bool b0 = lane & 1, b1 = lane & 2, b2 = lane & 4, b3 = lane & 8;
            float a8[8], a4[4], a2[2];
#pragma unroll
            for (int j = 0; j < 8; ++j) { const float keep = b0 ? ss[2 * j + 1] : ss[2 * j], send = b0 ? ss[2 * j] : ss[2 * j + 1]; a8[j] = keep + dppf<0xB1>(send); }
#pragma unroll
            for (int j = 0; j < 4; ++j) { const float keep = b1 ? a8[2 * j + 1] : a8[2 * j], send = b1 ? a8[2 * j] : a8[2 * j + 1]; a4[j] = keep + dppf<0x4E>(send); }
#pragma unroll
            for (int j = 0; j < 2; ++j) { const float keep = b2 ? a4[2 * j + 1] : a4[2 * j], send = b2 ? a4[2 * j] : a4[2 * j + 1];
                const int si = __builtin_bit_cast(int, send);
                const int t0 = __builtin_amdgcn_update_dpp(si, si, 0x104, 0xf, 0x5, false);
                const int t1 = __builtin_amdgcn_update_dpp(t0, si, 0x114, 0xf, 0xa, false);
                a2[j] = keep + __builtin_bit_cast(float, t1); }
            const float keep = b3 ? a2[1] : a2[0], send = b3 ? a2[0] : a2[1];
            ss[0] = xor16_sum(keep + dppf<0x128>(send));
        }
        if (r < 16) xb[wave * 32 + 8 * (r >> 2) + 4 * h + (r & 3)] = ss[0];
        asm volatile("s_waitcnt lgkmcnt(0)" ::: "memory"); __builtin_amdgcn_s_barrier(); asm volatile("" ::: "memory");
        }
        bf16_t* orow = OA + ((size_t)b * SEQ + g * (CPS * 32) + c * 32) * HGW + hh * 128 + vs * 32;
        const unsigned oo = (unsigned)(4 * h * HGW + r) * 2u;
#pragma unroll
        for (int i4 = 0; i4 < 4; ++i4) {
            f32x4 tot = *(const LAS f32x4*)(xb + (grp * 4 + 0) * 32 + 8 * i4 + 4 * h);
#pragma unroll
            for (int s = 1; s < 4; ++s) tot = tot + *(const LAS f32x4*)(xb + (grp * 4 + s) * 32 + 8 * i4 + 4 * h);
            const float gv[4] = {bflo(gq[i4].x), bfhi(gq[i4].x), bflo(gq[i4].y), bfhi(gq[i4].y)};
#pragma unroll
            for (int e2 = 0; e2 < 2; ++e2) { const int i = 4 * i4 + 2 * e2;
                const float sc0 = __builtin_amdgcn_rsqf(tot[2 * e2] * (1.0f / 128.0f) + EPS) * ogv, sc1 = __builtin_amdgcn_rsqf(tot[2 * e2 + 1] * (1.0f / 128.0f) + EPS) * ogv;
                const unsigned w = cvt_pk_bf16(O[i] * sc0 * gv[2 * e2], O[i + 1] * sc1 * gv[2 * e2 + 1]);
                *(bf16_t*)((char*)(orow + ((i & 3) + 8 * (i >> 2)) * HGW) + oo) = (bf16_t)(w & 0xffffu);
                *(bf16_t*)((char*)(orow + (((i + 1) & 3) + 8 * ((i + 1) >> 2)) * HGW) + oo) = (bf16_t)(w >> 16); } }
#pragma unroll
        for (int i4 = 0; i4 < 4; ++i4) gq[i4] = *(const u32x2*)((const char*)(GF + cn * 4096 + vs * 1024 + i4 * 256) + (lo16 >> 1));
    }
}

DI void attn_task(int b, int kvh, int gq, int qt, int lane, const bf16_t* AQ, const LAS unsigned char* kst, const bf16_t* AVT, const float* sinks, bf16_t* OB) {
    const int head = kvh * 4 + gq, r = lane & 31, h = lane >> 5;
    const unsigned lo16 = (unsigned)lane * 16u;
    const bf16_t* qblk = AQ + ((size_t)(b * 8 + head) * 256 + qt) * 2048;
    const bf16_t* vbase = AVT + (size_t)(b * 2 + kvh) * 256 * 2048;
    bf16x8 qf[4], kv[5][4];
#pragma unroll
    for (int ks = 0; ks < 4; ++ks) qf[ks] = ldfrag(qblk, ks, lo16);
#pragma unroll
    for (int kt = 0; kt < 5; ++kt)
#pragma unroll
        for (int ks = 0; ks < 4; ++ks) kv[kt][ks] = *(const LAS bf16x8*)(kst + (kt * 4 + ks) * 1024 + lo16);
    const float slope2 = __builtin_amdgcn_exp2f(-(float)(head + 1)) * LOG2E, sink2 = sinks[head] * LOG2E;
    f32x16 X[5];
    float mx = sink2;
    const int rbi = r - 4 * h; float rb = (float)rbi; asm volatile("" : "+v"(rb));
    SB0();
#pragma unroll
    for (int kt = 0; kt < 5; ++kt) {
        f32x16 x;
#pragma unroll
        for (int i = 0; i < 16; ++i) x[i] = 0.f;
#pragma unroll
        for (int ks = 0; ks < 4; ++ks) x = mfma32(kv[kt][ks], qf[ks], x);
        const bool tile_ok = qt - 4 + kt >= 0;
#pragma unroll
        for (int i = 0; i < 16; ++i) { const int ci = (i & 3) + 8 * (i >> 2);
            float v = x[i] - slope2 * (rb + (float)(128 - 32 * kt - ci));
            if (kt == 0 && !(ci > rbi)) v = -1e30f;
            if (kt == 4 && !(ci <= rbi)) v = -1e30f;
            if (!tile_ok) v = -1e30f;
            x[i] = v; mx = fmaxf(mx, v); }
        X[kt] = x;
    }
    SB0();
#pragma unroll
    for (int kt = 0; kt < 5; ++kt) { const int vn = qt - 4 + kt < 0 ? 0 : qt - 4 + kt;
#pragma unroll
        for (int f = 0; f < 4; ++f) kv[kt][f] = ldfrag(vbase + vn * 2048, f, lo16); }
    SB0();
    mx = xor32_max(mx);
    float l = 0.f;
#pragma unroll
    for (int kt = 0; kt < 5; ++kt)
#pragma unroll
        for (int i = 0; i < 16; ++i) { const float p = __builtin_amdgcn_exp2f(X[kt][i] - mx); X[kt][i] = p; l += p; }
    l = xor32_sum(l);
    l += __builtin_amdgcn_exp2f(sink2 - mx);
    f32x16 O[2];
#pragma unroll
    for (int dt = 0; dt < 2; ++dt)
#pragma unroll
        for (int i = 0; i < 16; ++i) O[dt][i] = 0.f;
    SB0();
#pragma unroll
    for (int kt = 0; kt < 5; ++kt) {
#pragma unroll
        for (int ks = 0; ks < 2; ++ks) { const bf16x8 pf = packstep(X[kt], ks);
#pragma unroll
            for (int dt = 0; dt < 2; ++dt) O[dt] = mfma32(pf, kv[kt][dt * 2 + ks], O[dt]); }
    }
    SB0();
    const float linv = __builtin_amdgcn_rcpf(l);
    bf16_t* orow = OB + ((size_t)b * SEQ + qt * 32) * ATW + head * 64;
    const unsigned oo = (unsigned)(4 * h * ATW + r) * 2u;
#pragma unroll
    for (int i = 0; i < 16; ++i) { const int t = crow(i, h); const float li = __shfl(linv, t);
        { const unsigned w = cvt_pk_bf16(O[0][i] * li, O[1][i] * li);
          *(bf16_t*)((char*)(orow + ((i & 3) + 8 * (i >> 2)) * ATW) + oo) = (bf16_t)(w & 0xffffu); *(bf16_t*)((char*)(orow + ((i & 3) + 8 * (i >> 2)) * ATW + 32) + oo) = (bf16_t)(w >> 16); } }
}

#define XB_TMO      128
#define XB_XCNT(j)  (256  + 64 * (j))
#define XB_XSUB(j)  (1280 + 64 * (j))
#define XB_XGEN(j)  (2304 + 64 * (j))
#define XB_TOP      3328
#define XB_TOPGEN   3392
#define XCD_BAR_WORDS 3456
#define XB_SPIN_CAP (1u << 18)
DI unsigned xb_ld(unsigned* p)              { return __hip_atomic_load(p, __ATOMIC_RELAXED, __HIP_MEMORY_SCOPE_AGENT); }
DI unsigned xb_add(unsigned* p, unsigned v) { return __hip_atomic_fetch_add(p, v, __ATOMIC_RELAXED, __HIP_MEMORY_SCOPE_AGENT); }
DI unsigned xb_xcc_id() { return (unsigned)__builtin_amdgcn_s_getreg((3 << 11) | 20) & 0xFu; }
#define XB_SPIN(cond, bar) do { unsigned _sp = 0; while (cond) { __builtin_amdgcn_s_sleep(1); \
    if ((++_sp & 255u) == 0u) { if (xb_ld(&(bar)[XB_TMO])) break; if (_sp > XB_SPIN_CAP) { atomicAdd(&(bar)[XB_TMO], 1u); break; } } } } while (0)
struct XcdBarrier { unsigned* bar; unsigned x; };
DI XcdBarrier xcd_barrier_post(unsigned* bar) {
    XcdBarrier b; b.bar = bar; b.x = xb_xcc_id();
    if (threadIdx.x == 0) (void)xb_add(&bar[XB_XCNT(b.x)], 1u);
    return b;
}
DI void xcd_barrier_complete(unsigned* bar, unsigned x, unsigned& nloc, unsigned& nx) {
    const unsigned G = gridDim.x * gridDim.y * gridDim.z;
    unsigned sum, cnt, mine, sp = 0u;
    for (;;) {
        sum = 0u; cnt = 0u; mine = 0u;
#pragma unroll
        for (unsigned j = 0; j < 16; ++j) { const unsigned c = xb_ld(&bar[XB_XCNT(j)]); sum += c; cnt += (c > 0u) ? 1u : 0u; mine = (j == x) ? c : mine; }
        if (sum == G) break;
        __builtin_amdgcn_s_sleep(1);
        if ((++sp & 255u) == 0u) { if (xb_ld(&bar[XB_TMO])) break; if (sp > XB_SPIN_CAP) { atomicAdd(&bar[XB_TMO], 1u); break; } }
    }
    nloc = mine > 0u ? mine : 1u; nx = cnt > 0u ? cnt : 1u;
}
DI void xcd_barrier(const XcdBarrier& b, const bool leader, unsigned& nloc, unsigned& nx) {
    asm volatile("s_waitcnt vmcnt(0)" ::: "memory");
    __syncthreads();
    if (leader) {
        unsigned* bar = b.bar;
        __builtin_amdgcn_s_waitcnt(0);
        if (nloc == 0u) xcd_barrier_complete(bar, b.x, nloc, nx);
        const unsigned old = xb_add(&bar[XB_XSUB(b.x)], 1u);
        const unsigned gen = old / nloc;
        if (old + 1u == (gen + 1u) * nloc) {
            __builtin_amdgcn_fence(__ATOMIC_RELEASE, "agent");
            asm volatile("s_waitcnt vmcnt(0)" ::: "memory");
            const unsigned og = xb_add(&bar[XB_TOP], 1u);
            const unsigned tg = og / nx;
            if (og + 1u == (tg + 1u) * nx) xb_add(&bar[XB_TOPGEN], 1u);
            else XB_SPIN(xb_ld(&bar[XB_TOPGEN]) == tg, bar);
            __builtin_amdgcn_fence(__ATOMIC_ACQUIRE, "agent");
            xb_add(&bar[XB_XGEN(b.x)], 1u);
            asm volatile("s_waitcnt vmcnt(0)" ::: "memory");
        } else {
            XB_SPIN(xb_ld(&bar[XB_XGEN(b.x)]) == gen, bar);
            __builtin_amdgcn_fence(__ATOMIC_ACQUIRE, "agent");
            asm volatile("s_waitcnt vmcnt(0)" ::: "memory");
        }
    }
    __syncthreads();
}

struct Args { const float* in[16]; float* out; unsigned char* ws; int ph_lo, ph_hi; };
constexpr int N_PHASES = 8;

__global__ void __launch_bounds__(NTHREADS, 2) fwd(Args args) {
    extern __shared__ __attribute__((aligned(16))) unsigned char lds_raw[];
    LAS unsigned char* lds = (LAS unsigned char*)lds_raw;
    const int wave = __builtin_amdgcn_readfirstlane(threadIdx.x >> 6);
    const int G = gridDim.x, bx = blockIdx.x;
    const int gw = bx * 8 + wave, NGW = G * 8;
    unsigned char* const ws = args.ws;
#define WSP(T, off) ((T*)(ws + (off)))

    const int lo = args.ph_lo, hi = args.ph_hi;
#define IN(k) (lo <= (k) && (k) < hi)
#define SEAM(k) do { if (IN(k) && IN((k) + 1)) { xcd_barrier(xbar, wave == 0 && lane_id() == 0, xb_nloc, xb_nx); xb_nloc = __builtin_amdgcn_readfirstlane(xb_nloc); xb_nx = __builtin_amdgcn_readfirstlane(xb_nx); } } while (0)
    unsigned xb_nloc = 0u, xb_nx = 0u;
    const XcdBarrier xbar = xcd_barrier_post((unsigned*)ws);

    if (IN(0)) {
        const int lane = lane_id(), tid = wave * 64 + lane;
        const float* x = args.in[0];
        bf16_t* WIN = WSP(bf16_t, WS_WIN); bf16_t* WA = WSP(bf16_t, WS_WA); bf16_t* WB = WSP(bf16_t, WS_WB); bf16_t* WOUT = WSP(bf16_t, WS_WOUT); bf16_t* WUP = WSP(bf16_t, WS_WUP); bf16_t* WDOWN = WSP(bf16_t, WS_WDOWN);
        bf16_t* XB = WSP(bf16_t, WS_XB); float* RMS1 = WSP(float, WS_RSTD1); float* SUMSQ2 = WSP(float, WS_SUMSQ2); float* LB = WSP(float, WS_LB);
        LAS float* scr = (LAS float*)(lds + wave * 16384);
        constexpr int I_IN = 16 * 152, I_A = 8 * 32, I_B = 8 * 32, I_OUT = 16 * 32, I_UP = 16 * 176, I_DN = 44 * 32;
        constexpr int NITEMS = I_IN + I_A + I_B + I_OUT + I_UP + I_DN;
        for (int pass = 0; pass < 2; ++pass) {
        if (((pass ^ wave) & 1) == 0) {
        for (int it = gw; it < NITEMS; it += NGW) {
            int r = it;
            if (r < I_IN) { const int kb = r / 152, nb = r % 152; transpose_item(args.in[2], DM, INC, colmap_in(32 * nb), WIN, 32 * nb, 64 * kb, args.in[1], scr, lane, in_colscale(32 * nb)); continue; } r -= I_IN;
            if (r < I_A) { const int kb = r / 32, nb = r % 32; transpose_item(args.in[8], 512, DM, 32 * nb, WA, 32 * nb, 64 * kb, nullptr, scr, lane); continue; } r -= I_A;
            if (r < I_B) { const int kb = r / 32, nb = r % 32; transpose_item(args.in[9], 512, DM, 32 * nb, WB, 32 * nb, 64 * kb, nullptr, scr, lane); continue; } r -= I_B;
            if (r < I_OUT) { const int kb = r / 32, nb = r % 32; transpose_item(args.in[10], DM, DM, 32 * nb, WOUT, 32 * nb, 64 * kb, nullptr, scr, lane); continue; } r -= I_OUT;
            if (r < I_UP) { const int kb = r / 176, nb = r % 176; transpose_item(args.in[12], DM, 2 * DFF, colmap_up(32 * nb), WUP, 32 * nb, 64 * kb, args.in[11], scr, lane); continue; } r -= I_UP;
            { const int kb = r / 32, nb = r % 32; transpose_item(args.in[15], DFF, DM, 32 * nb, WDOWN, 32 * nb, 64 * kb, nullptr, scr, lane); }
        }
        } else {
        for (int m0 = gw * 4; m0 < MTOK; m0 += NGW * 4) {
            f32x4 v[4][4]; float s[4];
#pragma unroll
            for (int q = 0; q < 4; ++q) { const f32x4* xr = (const f32x4*)(x + (size_t)(m0 + q) * DM) + lane;
#pragma unroll
                for (int j = 0; j < 4; ++j) v[q][j] = xr[64 * j]; }
#pragma unroll
            for (int q = 0; q < 4; ++q) { float a = 0.f;
#pragma unroll
                for (int j = 0; j < 4; ++j) a += (v[q][j].x * v[q][j].x + v[q][j].y * v[q][j].y) + (v[q][j].z * v[q][j].z + v[q][j].w * v[q][j].w);
                s[q] = a; }
#pragma unroll
            for (int o = 1; o < 64; o <<= 1)
#pragma unroll
                for (int q = 0; q < 4; ++q) s[q] += __shfl_xor(s[q], o);
#pragma unroll
            for (int q = 0; q < 4; ++q) { u32x2* o8 = (u32x2*)(XB + (size_t)(m0 + q) * DM) + lane; const float rs = __builtin_amdgcn_rsqf(s[q] * (1.0f / DM) + EPS);
#pragma unroll
                for (int j = 0; j < 4; ++j) { u32x2 w; w.x = cvt_pk_bf16(v[q][j].x * rs, v[q][j].y * rs); w.y = cvt_pk_bf16(v[q][j].z * rs, v[q][j].w * rs); o8[64 * j] = w; } }
            if (lane < 4) { const float sq = lane == 0 ? s[0] : lane == 1 ? s[1] : lane == 2 ? s[2] : s[3]; RMS1[m0 + lane] = __builtin_sqrtf(sq * (1.0f / DM) + EPS); SUMSQ2[m0 + lane] = 0.f; }
        }
        }
        }
        if (bx == 0) { const float l0 = args.in[3][tid], l1 = args.in[3][512 + tid]; LB[tid] = 1.0f / (1.0f + expf(l1 - l0)); }
    }
    SEAM(0);

    if (IN(1)) {
        SchedPlain S; S.T.init(MTOK / 256, INC / 256, G, bx); S.A = (const char*)(ws + WS_XB); S.Bt = (const char*)(ws + WS_WIN); S.atile = (size_t)256 * DM * 2; S.btile = (size_t)256 * DM * 2;
        EpiIn E{args.in[5], args.in[6], ws, lds, wave};
        pg8::gemm_phase<EpiIn, SchedPlain, 1>(lds, wave, DM, S, E);
    }
    SEAM(1);

    const int gi = bx * 2 + (wave >> 2), vs = wave & 3;
    if (IN(2)) {
        const int lane = lane_id();
        for (int slot = gw >> 2; slot < NB * 2 * 32; slot += NGW >> 2) {
            const int qg = slot & 31, kvh = (slot >> 5) & 1, b = slot >> 6;
            LAS unsigned char* kgrp = lds + (wave >> 2) * 49152;
            { const bf16_t* kbase = WSP(bf16_t, WS_AK) + (size_t)(b * 2 + kvh) * 256 * 2048;
#pragma unroll
              for (int k = 0; k < 12; ++k) { const int pce = (wave & 3) * 12 + k, tl = qg * 8 - 4 + (pce >> 2), kn = tl < 0 ? 0 : tl;
                  __builtin_amdgcn_global_load_lds((const unsigned*)((const char*)(kbase + (size_t)kn * 2048 + (pce & 3) * 512) + (unsigned)lane * 16u), (LAS unsigned*)(kgrp + pce * 1024), 16, 0, 0); }
              asm volatile("s_waitcnt vmcnt(0)" ::: "memory"); __syncthreads(); }
            for (int it = 0; it < 8; ++it) attn_task(b, kvh, wave & 3, qg * 8 + it, lane, WSP(bf16_t, WS_AQ), kgrp + it * 4096, WSP(bf16_t, WS_AV), args.in[7], WSP(bf16_t, WS_OB));
            __syncthreads();
        }
        LAS float* decl = (LAS float*)(lds + 4096) + (wave >> 2) * 2048;
        stage_vec(decl, WSP(float, WS_DEC), gi, vs, lane);
        __syncthreads();
        scan_pass_a(gi, vs, lane, lds, decl, WSP(bf16_t, WS_KBT), WSP(bf16_t, WS_VT), WSP(float, WS_DEC), WSP(float, WS_SLOC), WSP(float, WS_DSEG));
    }
    SEAM(2);

    if (IN(3)) {
        { LAS float* decl = (LAS float*)(lds + 4096) + (wave >> 2) * 2048; const int l_ = lane_id(); stage_vec(decl, WSP(float, WS_DEC), gi, vs, l_); stage_vec(decl + 4096, WSP(float, WS_EREF), gi, vs, l_); __syncthreads(); }
        scan_pass_b(gi, vs, wave, lane_id(), (LAS float*)lds, (LAS float*)(lds + 4096) + (wave >> 2) * 2048, WSP(bf16_t, WS_KA), WSP(bf16_t, WS_QA), WSP(bf16_t, WS_KBT), WSP(bf16_t, WS_VT), WSP(float, WS_DEC),
                    WSP(float, WS_SLOC), WSP(float, WS_DSEG), WSP(bf16_t, WS_G), args.in[4], WSP(bf16_t, WS_OA));
    }
    SEAM(3);

    if (IN(4)) {
        SchedPair S; S.T.init(MTOK / 256, DM / 256, G, bx); S.A0 = (const char*)(ws + WS_OA); S.A1 = (const char*)(ws + WS_OB); S.B0 = (const char*)(ws + WS_WA); S.B1 = (const char*)(ws + WS_WB); S.atile = (size_t)256 * 512 * 2; S.btile = (size_t)256 * 512 * 2;
        EpiBranch E{WSP(unsigned char, WS_GA), WSP(unsigned char, WS_GB), WSP(bf16_t, WS_MIXED)};
        pg8::gemm_phase<EpiBranch, SchedPair, 1>(lds, wave, 512, S, E);
    }
    SEAM(4);

    if (IN(5)) {
        SchedPlain S; S.T.init(MTOK / 256, DM / 256, G, bx); S.A = (const char*)(ws + WS_MIXED); S.Bt = (const char*)(ws + WS_WOUT); S.atile = (size_t)256 * DM * 2; S.btile = (size_t)256 * DM * 2;
        EpiOut E{WSP(bf16_t, WS_XB), WSP(float, WS_RSTD1), WSP(bf16_t, WS_X1B), WSP(float, WS_SUMSQ2)};
        pg8::gemm_phase<EpiOut, SchedPlain, 0>(lds, wave, DM, S, E);
    }
    SEAM(5);

    if (IN(6)) {
        SchedUp S; S.T.init(P4_NM, (2 * DFF) / 256, G, bx); S.A = (const char*)(ws + WS_X1B); S.Bt = (const char*)(ws + WS_WUP); S.btile = (size_t)256 * DM * 2;
        EpiUp E{WSP(float, WS_SUMSQ2), args.in[13], args.in[14], WSP(bf16_t, WS_ACT), lds};
        pg8::gemm_phase<EpiUp, SchedUp, 2>(lds, wave, DM, S, E);
    }
    SEAM(6);

    if (IN(7)) {
        SchedPlain S; S.T.init(MTOK / 256, DM / 256, G, bx); S.A = (const char*)(ws + WS_ACT); S.Bt = (const char*)(ws + WS_WDOWN); S.atile = (size_t)256 * DFF * 2; S.btile = (size_t)256 * DFF * 2;
        EpiDown E{WSP(bf16_t, WS_X1B), args.out};
        pg8::gemm_phase<EpiDown, SchedPlain, 0>(lds, wave, DFF, S, E);
    }
#undef IN
#undef SEAM
}

extern "C" void kernel_launch(void* const* d_in, const int* in_sizes, int n_in, void* d_out, int out_size, void* d_ws, size_t ws_size, hipStream_t stream) {
    static int grid = 0;
    if (grid == 0) {
        if (n_in != 16 || out_size != MTOK * DM || ws_size < WS_END) { fprintf(stderr, "kernel_launch: unexpected shapes (n_in %d out %d ws %zu)\n", n_in, out_size, ws_size); grid = -1; return; }
        int dev = 0, cus = 0, per_cu = 0;
        hipGetDevice(&dev);
        hipDeviceGetAttribute(&cus, hipDeviceAttributeMultiprocessorCount, dev);
        hipFuncSetAttribute((const void*)fwd, hipFuncAttributeMaxDynamicSharedMemorySize, LDS_BYTES);
        hipOccupancyMaxActiveBlocksPerMultiprocessor(&per_cu, (const void*)fwd, NTHREADS, LDS_BYTES);
        if (per_cu < 1) { fprintf(stderr, "kernel_launch: occupancy query says %d blocks per CU\n", per_cu); per_cu = 1; }
        (void)hipGetLastError();
        grid = cus * 1;
    }
    if (grid < 0) return;
    if (hipMemsetAsync(d_ws, 0, 65536, stream) != hipSuccess) { fprintf(stderr, "kernel_launch: memset of the barrier words failed\n"); return; }
    Args a{};
    for (int i = 0; i < 16; ++i) a.in[i] = (const float*)d_in[i];
    a.out = (float*)d_out; a.ws = (unsigned char*)d_ws;
#if MK_N_LAUNCHES == 1
    a.ph_lo = 0; a.ph_hi = N_PHASES;
    void* kargs[] = {&a};
    hipError_t e = hipLaunchCooperativeKernel((const void*)fwd, dim3(grid), dim3(NTHREADS), kargs, LDS_BYTES, stream);
    if (e != hipSuccess) fprintf(stderr, "kernel_launch: cooperative launch failed: %s (grid %d)\n", hipGetErrorString(e), grid);
#else
    for (int p = 0; p < N_PHASES; ++p) { a.ph_lo = p; a.ph_hi = p + 1; hipLaunchKernelGGL(fwd, dim3(grid), dim3(NTHREADS), LDS_BYTES, stream, a); }
#endif
}
```

```cpp
#include <hip/hip_runtime.h>
#include <cstdio>
#include <cstdint>

#define LAS __attribute__((address_space(3)))
#define DI __device__ __forceinline__
typedef unsigned short bf16_t;
typedef short bf16x8 __attribute__((ext_vector_type(8)));
typedef float f32x4 __attribute__((ext_vector_type(4)));
typedef float f32x2 __attribute__((ext_vector_type(2)));
typedef float f32x16 __attribute__((ext_vector_type(16)));
typedef unsigned u32x4 __attribute__((ext_vector_type(4)));
typedef unsigned u32x2 __attribute__((ext_vector_type(2)));


#ifndef MK_N_LAUNCHES
#define MK_N_LAUNCHES 1
#endif

constexpr int DM = 1024, NB = 8, SEQ = 8192, MTOK = NB * SEQ;
constexpr int INC = 4864, DFF = 2816, HGW = 512, ATW = 512, AKW = 128;
constexpr int HG_Q0 = 0, HG_F0 = 512, HG_I0 = 1024, HG_G0 = 1536, AT_Q0 = 2048, AT_K0 = 2560, AT_V0 = 2688, GATE_A0 = 2816, GATE_B0 = 3840;
constexpr float EPS = 1e-6f;
constexpr float LOG2E = 1.4426950408889634f;
constexpr float QSCALE = 0.125f * LOG2E;
constexpr int P4_TPS = 33;
constexpr int P4_NM = NB * P4_TPS;

constexpr size_t MiB = 1u << 20;
constexpr size_t WS_SMALL = 1 * MiB;
constexpr size_t WS_RSTD1 = WS_SMALL, WS_SUMSQ2 = WS_SMALL + 256 * 1024, WS_LB = WS_SMALL + 512 * 1024;
constexpr size_t WS_WIN = 2 * MiB;
constexpr size_t WS_WA = 12 * MiB;
constexpr size_t WS_WB = 13 * MiB;
constexpr size_t WS_WOUT = 14 * MiB;
constexpr size_t WS_WUP = 16 * MiB;
constexpr size_t WS_WDOWN = 28 * MiB;
constexpr size_t WS_XB = 36 * MiB;
constexpr size_t WS_OA = 937 * MiB, WS_OB = 292 * MiB;
constexpr size_t WS_KA = 164 * MiB;
constexpr size_t WS_QA = 228 * MiB;
constexpr size_t WS_X1B = 356 * MiB;
constexpr size_t WS_EREF = 1001 * MiB;
constexpr size_t WS_KBT = 356 * MiB;
constexpr size_t WS_MIXED = 164 * MiB;
constexpr size_t WS_G = 420 * MiB;
constexpr size_t WS_AQ = 484 * MiB;
constexpr size_t WS_AK = 548 * MiB;
constexpr size_t WS_AV = 564 * MiB;
constexpr size_t WS_GA = 580 * MiB;
constexpr size_t WS_GB = 708 * MiB;
constexpr size_t WS_VT = 836 * MiB;
constexpr size_t WS_DEC = 900 * MiB;
constexpr size_t WS_SLOC = 904 * MiB;
constexpr size_t WS_DSEG = 936 * MiB;
constexpr size_t WS_ACT = 580 * MiB;
constexpr size_t WS_END = 1024 * MiB;
constexpr int NSEG = 16, CPS = 16;

constexpr int LDS_BYTES = 163840;
constexpr int STG_OFF = 131072;
constexpr int NTHREADS = 512;

DI unsigned f2bf(float f) { unsigned u = __builtin_bit_cast(unsigned, f); return (u + 0x7fffu + ((u >> 16) & 1u)) >> 16; }
DI unsigned pk2(float lo, float hi) { return f2bf(lo) | (f2bf(hi) << 16); }
DI float bf2f(unsigned short b) { return __builtin_bit_cast(float, (unsigned)b << 16); }
DI float bflo(unsigned w) { return __builtin_bit_cast(float, w << 16); }
DI float bfhi(unsigned w) { return __builtin_bit_cast(float, w & 0xffff0000u); }
typedef __bf16 bf16x2_t __attribute__((ext_vector_type(2)));
DI unsigned cvt_pk_bf16(float lo, float hi) { f32x2 v = {lo, hi}; bf16x2_t b = __builtin_convertvector(v, bf16x2_t); return __builtin_bit_cast(unsigned, b); }
DI float fexp(float x) { return __builtin_amdgcn_exp2f(x * LOG2E); }
DI float sigmoidf_(float x) { return __builtin_amdgcn_rcpf(1.0f + fexp(-x)); }
DI float siluf_(float x) { return x * sigmoidf_(x); }
DI float sig2(float a) { return __builtin_amdgcn_rcpf(1.0f + __builtin_amdgcn_exp2f(a)); }
constexpr float NLN2 = -0.6931471805599453f;
DI float in_colscale(int n) { const int t = n >> 8; return (t < 4 || t == 6 || t == 7 || t >= 11) ? -LOG2E : 1.0f; }
DI int lane_id() { int l; asm volatile("v_mbcnt_lo_u32_b32 %0, -1, 0\n\tv_mbcnt_hi_u32_b32 %0, -1, %0" : "=v"(l)); return l; }
template <int CTRL> DI float dppf(float x) { return __builtin_bit_cast(float, __builtin_amdgcn_update_dpp(__builtin_bit_cast(int, x), __builtin_bit_cast(int, x), CTRL, 0xf, 0xf, false)); }
DI float xor16_sum(float x) { float a = x, b = x; asm volatile("s_nop 1\n\tv_permlane16_swap_b32 %0, %1" : "+v"(a), "+v"(b)); return a + b; }
DI float xor32_sum(float x) { float a = x, b = x; asm volatile("s_nop 1\n\tv_permlane32_swap_b32 %0, %1" : "+v"(a), "+v"(b)); return a + b; }
DI float xor32_max(float x) { float a = x, b = x; asm volatile("s_nop 1\n\tv_permlane32_swap_b32 %0, %1" : "+v"(a), "+v"(b)); return fmaxf(a, b); }
DI float wave_sum(float v) {
#pragma unroll
    for (int o = 1; o < 64; o <<= 1) v += __shfl_xor(v, o);
    return v;
}
DI u32x4 pack8(const f32x4& a, const f32x4& b) { u32x4 w; w.x = cvt_pk_bf16(a[0], a[1]); w.y = cvt_pk_bf16(a[2], a[3]); w.z = cvt_pk_bf16(b[0], b[1]); w.w = cvt_pk_bf16(b[2], b[3]); return w; }
DI void unpack8(const u32x4& w, f32x4& a, f32x4& b) { a = (f32x4){bflo(w.x), bfhi(w.x), bflo(w.y), bfhi(w.y)}; b = (f32x4){bflo(w.z), bfhi(w.z), bflo(w.w), bfhi(w.w)}; }
DI f32x2 gelu_pk(f32x2 v) {
    const f32x2 av = __builtin_elementwise_abs(v), d = av * 0.2316418882f + 1.0f;
    f32x2 t; t.x = __builtin_amdgcn_rcpf(d.x); t.y = __builtin_amdgcn_rcpf(d.y);
    f32x2 q = t * 0.5307027145f + (-0.7265760135f); q = q * t + 0.7107068705f; q = q * t + (-0.142248368f); q = q * t + 0.127414796f; q = q * t;
    const f32x2 s = (v * v) * (-0.72134752044f);
    f32x2 e; e.x = __builtin_amdgcn_exp2f(s.x); e.y = __builtin_amdgcn_exp2f(s.y);
    const f32x2 m = av * (q * e);
    f32x2 o; o.x = fmaxf(v.x, 0.f) - m.x; o.y = fmaxf(v.y, 0.f) - m.y; return o;
}

namespace pg8 {
constexpr int BM = 256, BK = 64, HALF = 128, HTB = HALF * BK * 2, STAGE_BYTES = 8 * HTB, NXCD = 8, WGM = 8;
__host__ __device__ __forceinline__ int lds_byte(int r, int c) { const int st = (r >> 4) * 2 + (c >> 5), rr = r & 15, cc = c & 31, ob = rr * 64 + cc * 2; return st * 1024 + (ob ^ (((ob >> 9) & 1) << 5)); }
__host__ __device__ __forceinline__ void stage_rc(int b, int& R, int& C) { const int st = b / 1024, sb = b % 1024, swz = sb ^ (((sb >> 9) & 1) << 5); R = (st >> 1) * 16 + swz / 64; C = (st & 1) * 32 + (swz % 64) / 2; }
__host__ __device__ __forceinline__ int perm32(int rho) { const int n = rho >> 4, i = rho & 15; return 8 * (i >> 2) + 4 * n + (i & 3); }

struct Unit { int pm, pn, part; };

struct TileOrder {
    int nM, nN, nwg, G, c;
    DI void init(int nM_, int nN_, int G_, int c_) { nM = nM_; nN = nN_; nwg = nM * nN; G = G_; c = c_; }
    DI bool tile(int i, int& pm, int& pn) const {
        const long L = (long)i * G + c; if (L >= nwg) return false;
        int wgid = (int)L; { const int q = nwg / NXCD, r = nwg % NXCD, xcd = wgid % NXCD, off = wgid / NXCD; wgid = (xcd < r ? xcd * (q + 1) : r * (q + 1) + (xcd - r) * q) + off; }
        const int nig = WGM * nN, gid = wgid / nig, fm = gid * WGM, gsz = (nM - fm) < WGM ? (nM - fm) : WGM;
        pm = fm + ((wgid % nig) % gsz); pn = (wgid % nig) / gsz; return true;
    }
};

template <int RM> DI int arow_of(int R) {
    if (RM == 0) return R;
    if (RM == 1) return 128 * (R >> 6) + 8 * (R & 15) + ((R >> 4) & 3);
    return 126 * (R >> 6) + 8 * (R & 15) + ((R >> 4) & 3);
}
template <int RM> constexpr int ahalf_rows() { return RM == 0 ? 128 : 4; }

template <class Epi, class Sched, int RM>
DI void gemm_phase(LAS unsigned char* lds, const int wid, const int K, const Sched& S, const Epi& E) {
    const int lane = lane_id(), tid = wid * 64 + lane, wr = wid >> 2, wc = wid & 3, fr = lane & 15, fq = lane >> 4;
    const int nt = K / BK;
    unsigned voffA[2], voffB[2];
#pragma unroll
    for (int i = 0; i < 2; ++i) { int R, C; stage_rc(tid * 16 + i * 8192, R, C); const int Rb = Epi::PERM ? ((R & ~31) + perm32(R & 31)) : R;
        voffA[i] = (unsigned)(arow_of<RM>(R) * K + C) * 2u; voffB[i] = (unsigned)(Rb * K + C) * 2u; }
    const size_t kstep = (size_t)(BK * 2);
    const size_t hstepA = (size_t)ahalf_rows<RM>() * K * 2, hstepB = (size_t)HALF * K * 2;
    const unsigned ldsw = (unsigned)wid * 1024u;
    const int aoff = lds_byte(wr * 64 + fr, fq * 8), boff = lds_byte(wc * 32 + fr, fq * 8);
#define PG8_SA(b, h) (((b) * 2 + (h)) * HTB)
#define PG8_SB(b, h) ((4 + (b) * 2 + (h)) * HTB)
#define PG8_STAGE(bufoff, gbase, voff) do { const char* _g = (const char*)(gbase); const unsigned _l0 = (unsigned)(size_t)(lds + (bufoff)) + ldsw; \
        asm volatile("s_mov_b32 m0, %3\n\ts_nop 0\n\tglobal_load_lds_dwordx4 %0, %2\n\ts_mov_b32 m0, %4\n\ts_nop 0\n\tglobal_load_lds_dwordx4 %1, %2" \
                     :: "v"((voff)[0]), "v"((voff)[1]), "s"(_g), "s"(_l0), "s"(_l0 + 8192u) : "memory", "m0"); } while (0)
#define PG8_LDA(dst, b, h) do { _Pragma("unroll") for (int m = 0; m < 4; ++m) _Pragma("unroll") for (int k = 0; k < 2; ++k) dst[m][k] = *(const LAS bf16x8*)(lds + PG8_SA(b, h) + aoff + m * 2048 + k * 1024); } while (0)
#define PG8_LDB(dst, b, h) do { _Pragma("unroll") for (int n = 0; n < 2; ++n) _Pragma("unroll") for (int k = 0; k < 2; ++k) dst[n][k] = *(const LAS bf16x8*)(lds + PG8_SB(b, h) + boff + n * 2048 + k * 1024); } while (0)
#define PG8_MMA(ai, bj, At, Bt) do { __builtin_amdgcn_s_setprio(1); _Pragma("unroll") for (int m = 0; m < 4; ++m) _Pragma("unroll") for (int n = 0; n < 2; ++n) _Pragma("unroll") for (int k = 0; k < 2; ++k) \
        acc[ai][bj][m][n] = __builtin_amdgcn_mfma_f32_16x16x32_bf16(Bt[n][k], At[m][k], acc[ai][bj][m][n], 0, 0, 0); __builtin_amdgcn_s_setprio(0); } while (0)
#define PG8_WAIT_V(n) asm volatile("s_waitcnt vmcnt(" #n ")" ::: "memory")
#define PG8_WAIT_L(n) asm volatile("s_waitcnt lgkmcnt(" #n ")" ::: "memory")
#define PG8_WAIT_VX(base) do { if constexpr (Epi::SX > 0) asm volatile("s_cmp_lg_u32 %0, 0\n\ts_cbranch_scc1 1f\n\ts_waitcnt vmcnt(%2)\n1:\n\ts_waitcnt vmcnt(%1)" :: "s"(sx), "n"((base) + Epi::SX), "n"(base) : "memory", "scc"); else asm volatile("s_waitcnt vmcnt(%0)" :: "n"(base) : "memory"); } while (0)
#define PG8_BAR __builtin_amdgcn_s_barrier()
#define PG8_SCHED __builtin_amdgcn_sched_barrier(0)
    Unit cur, nxt; int ui = 0, sxn = 0;
    if (!S.next(0, cur)) return;
    f32x4 acc[2][2][4][2];
#pragma unroll
    for (int a = 0; a < 2; ++a)
#pragma unroll
        for (int b = 0; b < 2; ++b)
#pragma unroll
            for (int m = 0; m < 4; ++m)
#pragma unroll
                for (int n = 0; n < 2; ++n) acc[a][b][m][n] = (f32x4){0.f, 0.f, 0.f, 0.f};
    bf16x8 At[4][2], B0[2][2], B1e[2][2], B1o[2][2];
    const char* cA = S.abase(cur); const char* cB = S.bbase(cur);
    PG8_STAGE(PG8_SB(0, 0), cB, voffB); PG8_STAGE(PG8_SB(0, 1), cB + hstepB, voffB); PG8_STAGE(PG8_SA(0, 0), cA, voffA); PG8_STAGE(PG8_SA(0, 1), cA + hstepA, voffA);
    PG8_STAGE(PG8_SB(1, 1), cB + hstepB + kstep, voffB); PG8_STAGE(PG8_SB(1, 0), cB + kstep, voffB); PG8_STAGE(PG8_SA(1, 0), cA + kstep, voffA);
    if (wr == 1) PG8_BAR;
    PG8_WAIT_V(0); PG8_BAR;
    PG8_BAR;
    for (;;) {
        const bool has_next = S.next(ui + 1, nxt);
        const char* nA = has_next ? S.abase(nxt) : cA; const char* nB = has_next ? S.bbase(nxt) : cB;
#define PG8_PAIR() do { \
              PG8_LDB(B0, 0, 0); PG8_SCHED; PG8_LDA(At, 0, 0); PG8_STAGE(PG8_SA(1, 1), a1 + hstepA, voffA); PG8_STAGE(PG8_SB(0, 1), b2 + hstepB, voffB); \
            PG8_WAIT_V(8); PG8_BAR; PG8_MMA(0, 0, At, B0); PG8_MMA(0, 1, At, B1e); PG8_BAR; PG8_SCHED; \
              PG8_LDA(At, 0, 1); PG8_LDB(B1o, 1, 1); PG8_STAGE(PG8_SB(0, 0), b2, voffB); PG8_STAGE(PG8_SA(0, 0), a2, voffA); \
            PG8_WAIT_V(8); PG8_BAR; PG8_MMA(1, 0, At, B0); PG8_MMA(1, 1, At, B1e); PG8_BAR; PG8_SCHED; \
            PG8_PAIR_TAIL(); } while (0)
#define PG8_PAIR_TAIL() do { \
              PG8_LDB(B0, 1, 0); PG8_SCHED; PG8_LDA(At, 1, 0); PG8_STAGE(PG8_SA(0, 1), a2 + hstepA, voffA); PG8_STAGE(PG8_SB(1, 1), b3 + hstepB, voffB); \
            PG8_WAIT_V(8); PG8_BAR; PG8_MMA(0, 0, At, B0); PG8_MMA(0, 1, At, B1o); PG8_BAR; PG8_SCHED; \
              PG8_LDA(At, 1, 1); PG8_LDB(B1e, 0, 1); PG8_STAGE(PG8_SB(1, 0), b3, voffB); PG8_STAGE(PG8_SA(1, 0), a3, voffA); \
            PG8_WAIT_V(8); PG8_BAR; PG8_MMA(1, 0, At, B0); PG8_MMA(1, 1, At, B1o); PG8_BAR; PG8_SCHED; } while (0)
#define PG8_PAIR_FIRST() do { \
              PG8_LDB(B0, 0, 0); PG8_LDB(B1e, 0, 1); PG8_SCHED; PG8_LDA(At, 0, 0); PG8_STAGE(PG8_SA(1, 1), a1 + hstepA, voffA); \
            PG8_WAIT_VX(6); PG8_BAR; PG8_MMA(0, 0, At, B0); PG8_MMA(0, 1, At, B1e); PG8_BAR; PG8_SCHED; \
              PG8_LDA(At, 0, 1); PG8_LDB(B1o, 1, 1); PG8_STAGE(PG8_SB(0, 1), b2 + hstepB, voffB); PG8_STAGE(PG8_SB(0, 0), b2, voffB); PG8_STAGE(PG8_SA(0, 0), a2, voffA); \
            PG8_WAIT_VX(8); PG8_BAR; PG8_MMA(1, 0, At, B0); PG8_MMA(1, 1, At, B1e); PG8_BAR; PG8_SCHED; \
            PG8_PAIR_TAIL(); } while (0)
        {
            const int sx = sxn; (void)sx;
            const char* a1 = cA + kstep; const char* a2 = cA + 2 * kstep; const char* b2 = cB + 2 * kstep; const char* a3 = a2 + kstep; const char* b3 = b2 + kstep;
            PG8_PAIR_FIRST();
        }
        for (int t = 2; t < nt; t += 2) {
            const bool last = (t == nt - 2);
            const char* a1 = cA + (size_t)(t + 1) * kstep;
            const char* a2 = last ? nA : cA + (size_t)(t + 2) * kstep; const char* b2 = last ? nB : cB + (size_t)(t + 2) * kstep;
            const char* a3 = a2 + kstep; const char* b3 = b2 + kstep;
            if (last) E.prefetch(lds, cur, wid, lane_id());
            PG8_PAIR();
        }
#undef PG8_PAIR
#undef PG8_PAIR_TAIL
#undef PG8_PAIR_FIRST
        if (wr == 0) PG8_BAR;
        { const int l2 = lane_id(); E(acc, cur, wr, wc, l2 & 15, l2 >> 4); }
        if (!has_next) break;
        if constexpr (Epi::SX > 0) sxn = E.nstore(cur);
        if (!E.keep(cur)) {
#pragma unroll
            for (int a = 0; a < 2; ++a)
#pragma unroll
                for (int b = 0; b < 2; ++b)
#pragma unroll
                    for (int m = 0; m < 4; ++m)
#pragma unroll
                        for (int n = 0; n < 2; ++n) acc[a][b][m][n] = (f32x4){0.f, 0.f, 0.f, 0.f};
        }
        cur = nxt; cA = nA; cB = nB; ++ui;
        if (wr == 1) PG8_BAR;
    }
    PG8_WAIT_V(0);
    PG8_BAR;
#undef PG8_SA
#undef PG8_SB
#undef PG8_STAGE
#undef PG8_LDA
#undef PG8_LDB
#undef PG8_MMA
#undef PG8_WAIT_V
#undef PG8_WAIT_L
#undef PG8_WAIT_VX
#undef PG8_BAR
#undef PG8_SCHED
}
}
using pg8::Unit;

struct SchedPlain {
    pg8::TileOrder T; const char* A; const char* Bt; size_t atile, btile;
    DI bool next(int i, Unit& u) const { u.part = 0; return T.tile(i, u.pm, u.pn); }
    DI const char* abase(const Unit& u) const { return A + (size_t)u.pm * atile; }
    DI const char* bbase(const Unit& u) const { return Bt + (size_t)u.pn * btile; }
};
struct SchedPair {
    pg8::TileOrder T; const char* A0; const char* A1; const char* B0; const char* B1; size_t atile, btile;
    DI bool next(int i, Unit& u) const { u.part = i & 1; return T.tile(i >> 1, u.pm, u.pn); }
    DI const char* abase(const Unit& u) const { return (u.part ? A1 : A0) + (size_t)u.pm * atile; }
    DI const char* bbase(const Unit& u) const { return (u.part ? B1 : B0) + (size_t)u.pn * btile; }
};
struct SchedUp {
    pg8::TileOrder T; const char* A; const char* Bt; size_t btile;
    DI bool next(int i, Unit& u) const { u.part = 0; return T.tile(i, u.pm, u.pn); }
    DI const char* abase(const Unit& u) const { const int b = u.pm / P4_TPS, j = u.pm % P4_TPS; return A + ((long)b * SEQ + 252 * j - 2) * (long)(DM * 2); }
    DI const char* bbase(const Unit& u) const { return Bt + (size_t)u.pn * btile; }
};

DI size_t gate_block(int pm, int ct, int wr, int wc) { return ((size_t)(((pm * 8 + ct) * 2 + wr) * 4 + wc)) * 4096; }
DI void gate_store(const f32x4 (&acc)[2][2][4][2], unsigned char* ga_blk, unsigned char* gb_blk, unsigned lo16) {
#pragma unroll
    for (int k = 0; k < 4; ++k) {
        u32x4 wa = (u32x4){0u, 0u, 0u, 0u}, wb = wa;
#pragma unroll
        for (int r = 0; r < 2; ++r) { const int ai = k >> 1, m = 2 * (k & 1) + r;
#pragma unroll
            for (int n = 0; n < 2; ++n)
                { unsigned ta[4], tb[4];
#pragma unroll
                    for (int e = 0; e < 4; ++e) { ta[e] = __builtin_bit_cast(unsigned, __builtin_fmaf(sig2(acc[ai][0][m][n][e]), 255.0f, 12582912.0f)); tb[e] = __builtin_bit_cast(unsigned, __builtin_fmaf(sig2(acc[ai][1][m][n][e]), 255.0f, 12582912.0f)); }
                    wa[2 * r + n] = __builtin_amdgcn_perm(__builtin_amdgcn_perm(ta[3], ta[2], 0x0c0c0400u), __builtin_amdgcn_perm(ta[1], ta[0], 0x0c0c0400u), 0x05040100u);
                    wb[2 * r + n] = __builtin_amdgcn_perm(__builtin_amdgcn_perm(tb[3], tb[2], 0x0c0c0400u), __builtin_amdgcn_perm(tb[1], tb[0], 0x0c0c0400u), 0x05040100u); } }
        *(u32x4*)(ga_blk + k * 1024 + lo16) = wa;
        *(u32x4*)(gb_blk + k * 1024 + lo16) = wb; }
}
DI void stg_put8(LAS char* stg, unsigned off, u32x2 w) { *(LAS u32x2*)(stg + off) = w; }
template <int SWZ> DI void stg_copy4k(LAS char* stg, char* g0, char* g1, unsigned lo16) {
    asm volatile("s_waitcnt lgkmcnt(0)" ::: "memory");
    const unsigned l0 = SWZ == 0 ? lo16 : (SWZ == 1 ? lo16 ^ (((lo16 >> 9) & 1u) << 4) : lo16 ^ (((lo16 >> 7) & 3u) << 4));
    constexpr unsigned x1 = SWZ == 0 ? 16u : (SWZ == 1 ? 32u : 0u), x2 = SWZ == 0 ? 32u : (SWZ == 1 ? 64u : 0u);
    const u32x4 a = *(const LAS u32x4*)(stg + l0), b = *(const LAS u32x4*)(stg + 1024 + (l0 ^ x1)), c = *(const LAS u32x4*)(stg + 2048 + (l0 ^ x2)), d = *(const LAS u32x4*)(stg + 3072 + (l0 ^ x1 ^ x2));
    *(u32x4*)(g0 + lo16) = a; *(u32x4*)(g0 + 1024 + lo16) = b; *(u32x4*)(g1 + lo16) = c; *(u32x4*)(g1 + 1024 + lo16) = d;
    asm volatile("s_waitcnt lgkmcnt(0)" ::: "memory");
}
DI void headnorm_store(const f32x4 (&acc)[2][2][4][2], int c4, int q4, int fq, int goff, float osc, LAS char* stg, char* g_c0, unsigned lo16) {
    const LAS float* gw = (const LAS float*)(stg + goff);
    const f32x4 g00 = *(const LAS f32x4*)(gw + 8 * fq), g01 = *(const LAS f32x4*)(gw + 8 * fq + 4), g10 = *(const LAS f32x4*)(gw + 32 + 8 * fq), g11 = *(const LAS f32x4*)(gw + 32 + 8 * fq + 4);
    asm volatile("s_waitcnt lgkmcnt(0)" ::: "memory");
    u32x4 pa[8], pb[8];
#pragma unroll
    for (int ai = 0; ai < 2; ++ai)
#pragma unroll
        for (int m = 0; m < 4; ++m) {
            f32x4 a0 = acc[ai][0][m][0], a1 = acc[ai][0][m][1], b0 = acc[ai][1][m][0], b1 = acc[ai][1][m][1];
            float ss = 0.f;
#pragma unroll
            for (int e = 0; e < 4; ++e) ss += a0[e] * a0[e] + a1[e] * a1[e] + b0[e] * b0[e] + b1[e] * b1[e];
            ss = xor32_sum(xor16_sum(ss));
            const float sc = __builtin_amdgcn_rsqf(ss * (1.0f / 64.0f) + EPS) * osc;
            pa[4 * ai + m] = pack8(a0 * sc * g00, a1 * sc * g01); pb[4 * ai + m] = pack8(b0 * sc * g10, b1 * sc * g11); }
    const unsigned loc = (((unsigned)(fq >> 1) * 512u + (8u * q4 + 32u * (fq & 1)) * 8u) * 2u) ^ ((unsigned)q4 << 4);
#pragma unroll
    for (int r = 0; r < 4; ++r) {
        if (c4 == r) {
#pragma unroll
            for (int j8 = 0; j8 < 8; ++j8) { const unsigned a_ = (loc ^ ((unsigned)(j8 & 3) << 4)) + (unsigned)(j8 >> 2) * 64u; *(LAS u32x4*)(stg + a_) = pa[j8]; *(LAS u32x4*)(stg + a_ + 2048) = pb[j8]; } }
        char* g = g_c0 + (size_t)r * 4096;
        stg_copy4k<2>(stg, g, g + 2048, lo16);
    }
}
template <int MODE> DI void tpiece_store(const f32x4 (&acc)[2][2][4][2], int bj, int c4, int q4, int fq, LAS char* stg, char* g_c0, size_t cstride, unsigned lo16) {
    const unsigned loc = (MODE == 1 ? (((unsigned)q4 * 256u + 8u * fq * 4u) * 2u) ^ ((unsigned)q4 << 4) ^ ((unsigned)(c4 & 1) << 6)
                                    : (((unsigned)(q4 >> 1) * 512u + 8u * fq * 8u + 4u * (q4 & 1)) * 2u) ^ ((unsigned)(q4 >> 1) << 4) ^ ((unsigned)(c4 & 1) << 5)) + (unsigned)(c4 & 1) * 2048u;
    u32x2 w[2][4][2];
#pragma unroll
    for (int n = 0; n < 2; ++n)
#pragma unroll
        for (int e = 0; e < 4; ++e)
#pragma unroll
            for (int ai = 0; ai < 2; ++ai) { float v0 = acc[ai][bj][0][n][e], v1 = acc[ai][bj][1][n][e], v2 = acc[ai][bj][2][n][e], v3 = acc[ai][bj][3][n][e];
                if (MODE == 1) { v0 = v0 * NLN2 * sig2(v0); v1 = v1 * NLN2 * sig2(v1); v2 = v2 * NLN2 * sig2(v2); v3 = v3 * NLN2 * sig2(v3); }
                w[n][e][ai].x = cvt_pk_bf16(v0, v1); w[n][e][ai].y = cvt_pk_bf16(v2, v3); }
#pragma unroll
    for (int r2 = 0; r2 < 2; ++r2) {
        if ((c4 >> 1) == r2) {
#pragma unroll
            for (int n = 0; n < 2; ++n)
#pragma unroll
                for (int e = 0; e < 4; ++e) {
                    const unsigned b_ = MODE == 1 ? (loc ^ ((unsigned)(2 * n + (e >> 1)) << 4)) + (unsigned)(e & 1) * 8u : (loc ^ ((unsigned)e << 4)) + (unsigned)n * 64u;
#pragma unroll
                    for (int ai = 0; ai < 2; ++ai) stg_put8(stg, b_ + (unsigned)ai * (MODE == 1 ? 256u : 512u), w[n][e][ai]); } }
        stg_copy4k<MODE>(stg, g_c0 + (size_t)(2 * r2) * cstride, g_c0 + (size_t)(2 * r2 + 1) * cstride, lo16);
    }
}
DI void qf_store(const f32x4 (&acc)[2][2][4][2], int pm, int head, int wr, int wc, int fr, int fq, const float* lb, bf16_t* KA, bf16_t* QA, float* EREF, bf16_t* KBT, float* DEC, LAS char* stg) {
    const int b = pm >> 5, cw = ((pm & 31) << 3) + 4 * wr, c4 = fr >> 2, q4 = fr & 3;
    const unsigned cbw = (unsigned)((b * 4 + head) * 256 + cw), cb = cbw + c4;
    const int dk0 = 32 * wc + 8 * fq;
    const unsigned lane = (unsigned)(fq * 16 + fr), lo16 = lane * 16u, lh = lane >> 5, ll16 = (lane & 31u) * 16u;
    const f32x4 l0 = *(const LAS f32x4*)(stg + dk0 * 4), l1 = *(const LAS f32x4*)(stg + dk0 * 4 + 16);
    asm volatile("s_waitcnt lgkmcnt(0)" ::: "memory");
    const unsigned hb = (dk0 >> 3) & 1;
    const unsigned kq_l = ((((unsigned)(fq >> 1) * 512u + 4u * hb + 8u * q4 * 8u) * 2u) ^ ((unsigned)q4 << 4) ^ ((unsigned)(c4 & 1) << 6)) + (unsigned)(c4 & 1) * 2048u;
    const unsigned kb_l = ((((unsigned)(q4 >> 1) * 512u + 8u * fq * 8u + 4u * (q4 & 1)) * 2u) ^ ((unsigned)(q4 >> 1) << 4) ^ ((unsigned)(c4 & 1) << 5)) + (unsigned)(c4 & 1) * 2048u;
    u32x2 pkb[8][2];
#pragma unroll
    for (int n = 0; n < 2; ++n) {
        unsigned pqa[8][2], pka[8][2];
#pragma unroll
        for (int ep = 0; ep < 2; ++ep) {
            float qa[2][8], ka[2][8];
#pragma unroll
            for (int eo = 0; eo < 2; ++eo) { const int e = 2 * ep + eo; const float lbv = n ? l1[e] : l0[e];
                float qh[8], kk[8], cum[8];
                float run = 1.f;
#pragma unroll
                for (int j8 = 0; j8 < 8; ++j8) { const int ai = j8 >> 2, m = j8 & 3;
                    const float f = lbv + (1.0f - lbv) * sig2(acc[ai][1][m][n][e]);
                    qh[j8] = acc[ai][0][m][n][e] * (NLN2 * 0.08838834764831845f) * sig2(acc[ai][0][m][n][e]); kk[j8] = 1.0f - f;
                    run *= f; cum[j8] = run; }
                const float t1 = dppf<0x90>(run), t2 = dppf<0x44>(run), t3 = dppf<0x24>(run);
                const float excl = (q4 >= 1 ? t1 : 1.f) * (q4 >= 2 ? t2 : 1.f) * (q4 >= 3 ? t3 : 1.f);
                const float c7 = excl * run;
                const float ref = dppf<0x55>(c7), cend = dppf<0xFF>(c7);
                float kb[8];
                const float rref = __builtin_amdgcn_rcpf(ref), eref = ref, ecr = cend * rref;
#pragma unroll
                for (int j8 = 0; j8 < 8; ++j8) { const float e1 = (excl * cum[j8]) * rref, r1 = __builtin_amdgcn_rcpf(e1);
                    qa[eo][j8] = qh[j8] * e1; ka[eo][j8] = kk[j8] * r1; kb[j8] = ka[eo][j8] * ecr; }
                const unsigned dk = dk0 + 4 * n + e;
                if (q4 == 3) { DEC[cb * 128u + dk] = cend; EREF[cb * 128u + dk] = eref; }
#pragma unroll
                for (int ai = 0; ai < 2; ++ai) { pkb[4 * n + e][ai].x = cvt_pk_bf16(kb[4 * ai], kb[4 * ai + 1]); pkb[4 * n + e][ai].y = cvt_pk_bf16(kb[4 * ai + 2], kb[4 * ai + 3]); }
            }
#pragma unroll
            for (int j8 = 0; j8 < 8; ++j8) { pqa[j8][ep] = cvt_pk_bf16(qa[0][j8], qa[1][j8]); pka[j8][ep] = cvt_pk_bf16(ka[0][j8], ka[1][j8]); }
        }
#pragma unroll
        for (int arr = 0; arr < 2; ++arr) { char* gb = (char*)(arr ? QA : KA);
#pragma unroll
            for (int r2 = 0; r2 < 2; ++r2) {
                if ((c4 >> 1) == r2) {
#pragma unroll
                    for (int j8 = 0; j8 < 8; ++j8) stg_put8(stg, (kq_l ^ ((unsigned)j8 << 4)) + (unsigned)n * 512u, arr ? (u32x2){pqa[j8][0], pqa[j8][1]} : (u32x2){pka[j8][0], pka[j8][1]}); }
                asm volatile("s_waitcnt lgkmcnt(0)" ::: "memory");
#pragma unroll
                for (int k = 0; k < 2; ++k) { const unsigned run = 2u * k + lh, img = run >> 1, frag = run & 1u;
                    const u32x4 v = *(const LAS u32x4*)(stg + img * 2048u + frag * 1024u + (unsigned)n * 512u + (ll16 ^ (((ll16 >> 7) & 3u) << 4) ^ (img << 6)));
                    *(u32x4*)(gb + ((size_t)(cbw + 2 * r2 + img) * 4096 + (2 * wc + frag) * 512) * 2 + n * 512 + ll16) = v; }
                asm volatile("s_waitcnt lgkmcnt(0)" ::: "memory");
            } }
    }
#pragma unroll
    for (int r2 = 0; r2 < 2; ++r2) {
        if ((c4 >> 1) == r2) {
#pragma unroll
            for (int col = 0; col < 8; ++col)
#pragma unroll
                for (int ai = 0; ai < 2; ++ai) stg_put8(stg, (kb_l ^ ((unsigned)(col & 3) << 4)) + (unsigned)(col >> 2) * 64u + (unsigned)ai * 512u, pkb[col][ai]); }
        stg_copy4k<0>(stg, (char*)KBT + ((size_t)(cbw + 2 * r2) * 4096 + 2 * wc * 512) * 2, (char*)KBT + ((size_t)(cbw + 2 * r2 + 1) * 4096 + 2 * wc * 512) * 2, lo16);
    }
}
struct EpiIn {
    static constexpr bool PERM = true;
    DI void prefetch(LAS unsigned char* l, const Unit& u, int wid, int lane) const {
        const float* lbp = (const float*)(ws + WS_LB) + 128 * (u.pn < 4 ? u.pn : 3);
        const float* src = lane < 32 ? lbp + lane * 4 : (lane < 48 ? qg + (lane - 32) * 4 : kg + (lane - 48) * 4);
        __builtin_amdgcn_global_load_lds((const unsigned*)src, (LAS unsigned*)(l + STG_OFF + wid * 4096), 16, 0, 0);
    }
    const float* qg; const float* kg;
    unsigned char* ws; LAS unsigned char* lds; int wave;
    DI bool keep(const Unit&) const { return false; }
    static constexpr int SX = 8;
    DI int nstore(const Unit&) const { return 1; }
    DI void operator()(f32x4 (&acc)[2][2][4][2], const Unit& u, int wr, int wc, int fr, int fq) const {
        bf16_t* KA = (bf16_t*)(ws + WS_KA); bf16_t* QA = (bf16_t*)(ws + WS_QA); float* EREF = (float*)(ws + WS_EREF); bf16_t* KBT = (bf16_t*)(ws + WS_KBT); bf16_t* VT = (bf16_t*)(ws + WS_VT);
        bf16_t* G = (bf16_t*)(ws + WS_G); bf16_t* AQ = (bf16_t*)(ws + WS_AQ); bf16_t* AK = (bf16_t*)(ws + WS_AK); bf16_t* AV = (bf16_t*)(ws + WS_AV); bf16_t* GA = (bf16_t*)(ws + WS_GA); bf16_t* GB = (bf16_t*)(ws + WS_GB);
        float* DEC = (float*)(ws + WS_DEC); const float* lb = (const float*)(ws + WS_LB);
        LAS char* stg = (LAS char*)(lds + STG_OFF + wave * 4096);
        const int rowb = u.pm * 256 + 128 * wr + 8 * fr;
        const int c8 = 32 * wc + 8 * fq;
        const int pn = u.pn;
        const int b = u.pm >> 5, cw = ((u.pm & 31) << 3) + 4 * wr, c4 = fr >> 2, q4 = fr & 3;
        const unsigned lo16 = (unsigned)(fq * 16 + fr) * 16u;
        if (pn < 4) {
            qf_store(acc, u.pm, pn, wr, wc, fr, fq, lb, KA, QA, EREF, KBT, DEC, stg);
        } else if (pn < 6) {
#pragma unroll
            for (int bj = 0; bj < 2; ++bj)
                tpiece_store<0>(acc, bj, c4, q4, fq, stg, (char*)VT + (((size_t)(b * 4 + 2 * (pn - 4) + bj) * 256 + cw) * 4096 + wc * 1024) * 2, (size_t)8192, lo16);
        } else if (pn < 8) {
#pragma unroll
            for (int bj = 0; bj < 2; ++bj)
                tpiece_store<1>(acc, bj, c4, q4, fq, stg, (char*)G + (((size_t)(b * 4 + 2 * (pn - 6) + bj) * 256 + cw) * 4096 + wc * 1024) * 2, (size_t)8192, lo16);
        } else if (pn < 10) {
            headnorm_store(acc, c4, q4, fq, 512, QSCALE, stg, (char*)AQ + ((size_t)(b * 8 + 4 * (pn - 8) + wc) * 256 + cw) * 4096, lo16);
        } else if (pn == 10) {
            if (wc < 2) headnorm_store(acc, c4, q4, fq, 768, 1.0f, stg, (char*)AK + ((size_t)(b * 2 + wc) * 256 + cw) * 4096, lo16);
            else {
#pragma unroll
                for (int bj = 0; bj < 2; ++bj)
                    tpiece_store<0>(acc, bj, c4, q4, fq, stg, (char*)AV + (((size_t)(b * 2 + wc - 2) * 256 + cw) * 2048 + bj * 1024) * 2, (size_t)4096, lo16); }
        } else {
            gate_store(acc, (unsigned char*)GA + gate_block(u.pm, pn - 11, wr, wc), (unsigned char*)GB + gate_block(u.pm, pn - 11, wr, wc), lo16);
        }
    }
};


struct EpiBranch {
    static constexpr bool PERM = true;
    DI void prefetch(LAS unsigned char*, const Unit&, int, int) const {}
    const unsigned char* GA8; const unsigned char* GB8; bf16_t* MIXED;
    DI bool keep(const Unit& u) const { return u.part == 0; }
    static constexpr int SX = 16;
    DI int nstore(const Unit& u) const { return u.part; }
    DI void operator()(f32x4 (&acc)[2][2][4][2], const Unit& u, int wr, int wc, int fr, int fq) const {
        const int rowb = u.pm * 256 + 128 * wr + 8 * fr, colb = u.pn * 256 + 32 * wc + 8 * fq;
        const unsigned lo16 = (unsigned)(fq * 16 + fr) * 16u;
        u32x4 gb[2][4], ga[2][4];
#pragma unroll
        for (int bj = 0; bj < 2; ++bj) { const size_t blk = gate_block(u.pm, 2 * u.pn + bj, wr, wc);
#pragma unroll
            for (int k = 0; k < 4; ++k) { gb[bj][k] = *(const u32x4*)(GB8 + blk + k * 1024 + lo16); if (u.part == 0) ga[bj][k] = *(const u32x4*)(GA8 + blk + k * 1024 + lo16); } }
        __builtin_amdgcn_sched_barrier(0);
#pragma unroll
        for (int ai = 0; ai < 2; ++ai)
#pragma unroll
            for (int m = 0; m < 4; ++m) { const size_t off = (size_t)(rowb + 4 * ai + m) * DM + colb; const int k = 2 * ai + (m >> 1), r = m & 1;
#pragma unroll
                for (int bj = 0; bj < 2; ++bj) {
                    f32x4 g0, g1;
                    const unsigned b0 = gb[bj][k][2 * r], b1 = gb[bj][k][2 * r + 1];
                    g0 = (f32x4){(float)(b0 & 255u), (float)((b0 >> 8) & 255u), (float)((b0 >> 16) & 255u), (float)(b0 >> 24)};
                    g1 = (f32x4){(float)(b1 & 255u), (float)((b1 >> 8) & 255u), (float)((b1 >> 16) & 255u), (float)(b1 >> 24)};
#pragma unroll
                    for (int e = 0; e < 4; ++e) { g0[e] = fmaxf(g0[e], 0.5f); g1[e] = fmaxf(g1[e], 0.5f); }
                    if (u.part == 0) {
                        const unsigned a0 = ga[bj][k][2 * r], a1 = ga[bj][k][2 * r + 1];
                        const f32x4 h0 = (f32x4){(float)(a0 & 255u), (float)((a0 >> 8) & 255u), (float)((a0 >> 16) & 255u), (float)(a0 >> 24)};
                        const f32x4 h1 = (f32x4){(float)(a1 & 255u), (float)((a1 >> 8) & 255u), (float)((a1 >> 16) & 255u), (float)(a1 >> 24)};
#pragma unroll
                        for (int e = 0; e < 4; ++e) { acc[ai][bj][m][0][e] *= h0[e] * __builtin_amdgcn_rcpf(g0[e]); acc[ai][bj][m][1][e] *= h1[e] * __builtin_amdgcn_rcpf(g1[e]); }
                    } else *(u32x4*)(MIXED + off + 128 * bj) = pack8(acc[ai][bj][m][0] * g0 * (1.0f / 255.0f), acc[ai][bj][m][1] * g1 * (1.0f / 255.0f));
                } }
    }
};

struct EpiOut {
    static constexpr bool PERM = true;
    DI void prefetch(LAS unsigned char*, const Unit&, int, int) const {}
    const bf16_t* XN; const float* rms; bf16_t* X1B; float* sumsq;
    DI bool keep(const Unit&) const { return false; }
    static constexpr int SX = 0;
    DI int nstore(const Unit&) const { return 1; }
    DI void operator()(f32x4 (&acc)[2][2][4][2], const Unit& u, int wr, int wc, int fr, int fq) const {
        const int rowb = u.pm * 256 + 64 * wr + fr, colb = u.pn * 256 + 32 * wc + 8 * fq;
        u32x4 xr[2][4][2]; float rr[2][4];
#pragma unroll
        for (int ai = 0; ai < 2; ++ai)
#pragma unroll
            for (int m = 0; m < 4; ++m) { const int row = rowb + 128 * ai + 16 * m; rr[ai][m] = rms[row];
#pragma unroll
                for (int bj = 0; bj < 2; ++bj) xr[ai][m][bj] = *(const u32x4*)(XN + (size_t)row * DM + colb + 128 * bj); }
        __builtin_amdgcn_sched_barrier(0);
#pragma unroll
        for (int ai = 0; ai < 2; ++ai)
#pragma unroll
            for (int m = 0; m < 4; ++m) { const int row = rowb + 128 * ai + 16 * m; const size_t off = (size_t)row * DM + colb; float ss = 0.f;
#pragma unroll
                for (int bj = 0; bj < 2; ++bj) {
                    f32x4 x0, x1; unpack8(xr[ai][m][bj], x0, x1);
                    const f32x4 a = acc[ai][bj][m][0] + x0 * rr[ai][m], b = acc[ai][bj][m][1] + x1 * rr[ai][m];
                    *(u32x4*)(X1B + off + 128 * bj) = pack8(a, b);
#pragma unroll
                    for (int e = 0; e < 4; ++e) ss += a[e] * a[e] + b[e] * b[e]; }
                ss = xor32_sum(xor16_sum(ss));
                if (fq == 0) atomicAdd(sumsq + row, ss); }
    }
};

struct EpiUp {
    static constexpr bool PERM = true;
    const float* sumsq; const float* cw; const float* cb; bf16_t* ACT; LAS unsigned char* lds;
    DI bool keep(const Unit&) const { return false; }
    static constexpr int SX = 8;
    DI int nstore(const Unit&) const { return 1; }
    DI void prefetch(LAS unsigned char* l, const Unit& u, int wid, int lane) const {
        LAS unsigned char* st = l + STG_OFF;
        if (wid == 0) { const int b = u.pm / P4_TPS, j = u.pm % P4_TPS;
#pragma unroll
            for (int q = 0; q < 4; ++q) { int tau = 252 * j - 2 + q * 64 + lane; tau = tau < 0 ? 0 : (tau > SEQ - 1 ? SEQ - 1 : tau);
                __builtin_amdgcn_global_load_lds((const unsigned*)(sumsq + (size_t)b * SEQ + tau), (LAS unsigned*)(st + q * 256), 4, 0, 0); }
        } else if (wid == 1) {
            __builtin_amdgcn_global_load_lds((const unsigned*)(cw + (size_t)(lane >> 5) * DFF + 128 * u.pn + (lane & 31) * 4), (LAS unsigned*)(st + 1024), 16, 0, 0);
        } else if (wid == 2) {
            __builtin_amdgcn_global_load_lds((const unsigned*)((lane < 32 ? cw + 2 * DFF : cb) + 128 * u.pn + (lane & 31) * 4), (LAS unsigned*)(st + 2048), 16, 0, 0);
        }
    }
    DI void operator()(f32x4 (&acc)[2][2][4][2], const Unit& u, int wr, int wc, int fr, int fq) const {
        const int b = u.pm / P4_TPS, j = u.pm % P4_TPS;
        const int tau0 = 252 * j + 126 * wr - 2 + 8 * fr;
        const int col = 128 * u.pn + 32 * wc + 8 * fq;
        const LAS unsigned char* st = lds + STG_OFF;
        const unsigned dumpoff = (unsigned)(352u * 1024u * 1024u) + (unsigned)(fq * 16 + fr) * 16u;
        float rs[8];
#pragma unroll
        for (int k = 0; k < 8; ++k) { const int tau = tau0 + k; const bool ok = tau >= 0 && tau < SEQ; const float s = *(const LAS float*)(st + (126 * wr + 8 * fr + k) * 4);
            rs[k] = ok ? __builtin_amdgcn_rsqf(s * (1.0f / DM) + EPS) : 0.f; }
        f32x4 w0[2], w1[2], w2[2], bb[2];
#pragma unroll
        for (int n = 0; n < 2; ++n) { const int lc = (32 * wc + 8 * fq + 4 * n) * 4; w0[n] = *(const LAS f32x4*)(st + 1024 + lc); w1[n] = *(const LAS f32x4*)(st + 1536 + lc); w2[n] = *(const LAS f32x4*)(st + 2048 + lc); bb[n] = *(const LAS f32x4*)(st + 2560 + lc); }
        f32x4 g[8][2];
#pragma unroll
        for (int ai = 0; ai < 2; ++ai)
#pragma unroll
            for (int m = 0; m < 4; ++m)
#pragma unroll
                for (int n = 0; n < 2; ++n) { const int k = 4 * ai + m; f32x4 v = acc[ai][0][m][n] * rs[k]; if (rs[k] == 0.f) v = (f32x4){0.f, 0.f, 0.f, 0.f}; g[k][n] = v; }
        f32x4 gm1[2], gm2[2];
#pragma unroll
        for (int n = 0; n < 2; ++n)
#pragma unroll
            for (int e = 0; e < 4; ++e) { gm1[n][e] = dppf<0x111>(g[7][n][e]); gm2[n][e] = dppf<0x111>(g[6][n][e]); }
#pragma unroll
        for (int k = 0; k < 8; ++k) {
            const int tau = tau0 + k; const int loc = 8 * fr + k;
            const int ai = k >> 2, m = k & 3;
            u32x4 w;
            f32x4 o[2];
#pragma unroll
            for (int n = 0; n < 2; ++n) {
                const f32x4 p1 = (k >= 1) ? g[k >= 1 ? k - 1 : 0][n] : gm1[n];
                const f32x4 p2 = (k >= 2) ? g[k >= 2 ? k - 2 : 0][n] : (k == 1 ? gm1[n] : gm2[n]);
                const f32x4 cv = bb[n] + w0[n] * p2 + w1[n] * p1 + w2[n] * g[k][n];
                const f32x4 vv = acc[ai][1][m][n] * rs[k];
                const f32x2 ga = gelu_pk((f32x2){cv[0], cv[1]}), gbv = gelu_pk((f32x2){cv[2], cv[3]});
                o[n] = (f32x4){ga.x * vv[0], ga.y * vv[1], gbv.x * vv[2], gbv.y * vv[3]};
            }
            w = pack8(o[0], o[1]);
            const bool ok = loc >= 2 && tau >= 0 && tau < SEQ;
            const unsigned off = ok ? ((unsigned)(b * SEQ + tau) * (unsigned)DFF + (unsigned)col) * 2u : dumpoff;
            *(u32x4*)((char*)ACT + off) = w;
        }
    }
};

struct EpiDown {
    static constexpr bool PERM = true;
    DI void prefetch(LAS unsigned char*, const Unit&, int, int) const {}
    const bf16_t* X1B; float* out;
    DI bool keep(const Unit&) const { return false; }
    static constexpr int SX = 32;
    DI int nstore(const Unit&) const { return 1; }
    DI void operator()(f32x4 (&acc)[2][2][4][2], const Unit& u, int wr, int wc, int fr, int fq) const {
        const int rowb = u.pm * 256 + 64 * wr + fr, colb = u.pn * 256 + 32 * wc + 8 * fq;
        u32x4 rsd[2][4][2];
#pragma unroll
        for (int ai = 0; ai < 2; ++ai)
#pragma unroll
            for (int m = 0; m < 4; ++m)
#pragma unroll
                for (int bj = 0; bj < 2; ++bj) rsd[ai][m][bj] = *(const u32x4*)(X1B + (size_t)(rowb + 128 * ai + 16 * m) * DM + colb + 128 * bj);
        __builtin_amdgcn_sched_barrier(0);
#pragma unroll
        for (int ai = 0; ai < 2; ++ai)
#pragma unroll
            for (int m = 0; m < 4; ++m) { const size_t off = (size_t)(rowb + 128 * ai + 16 * m) * DM + colb;
#pragma unroll
                for (int bj = 0; bj < 2; ++bj) {
                    f32x4 r0, r1; unpack8(rsd[ai][m][bj], r0, r1);
                    *(f32x4*)(out + off + 128 * bj) = acc[ai][bj][m][0] + r0; *(f32x4*)(out + off + 128 * bj + 4) = acc[ai][bj][m][1] + r1; } }
    }
};

DI int colmap_in(int n) {
    const int t = n >> 8, j = n & 255;
    if (t < 4) return j < 128 ? HG_Q0 + 128 * t + j : HG_F0 + 128 * t + (j - 128);
    if (t < 8) return HG_I0 + 256 * (t - 4) + j;
    const int bj = j >> 7, wc = (j >> 5) & 3, e = j & 31;
    if (t < 10) return AT_Q0 + 64 * (4 * (t - 8) + wc) + 32 * bj + e;
    if (t == 10) return wc < 2 ? AT_K0 + 64 * wc + 32 * bj + e : AT_V0 + 64 * (wc - 2) + 32 * bj + e;
    return j < 128 ? GATE_A0 + 128 * (t - 11) + j : GATE_B0 + 128 * (t - 11) + (j - 128);
}
DI int colmap_up(int n) { const int t = n >> 8, j = n & 255; return j < 128 ? 128 * t + j : DFF + 128 * t + (j - 128); }
DI void transpose_item(const float* W, int Kd, int Nsrc, int n0s, bf16_t* WT, int n0d, int k0, const float* gk, LAS float* scr, int lane, float cs = 1.0f) {
#pragma unroll 8
    for (int i = 0; i < 32; ++i) { const int kk = 2 * i + (lane >> 5); float v = W[(size_t)(k0 + kk) * Nsrc + n0s + (lane & 31)]; if (gk) v *= gk[k0 + kk] * cs; scr[kk * 33 + (lane & 31)] = v; }
    asm volatile("s_waitcnt lgkmcnt(0)" ::: "memory");
    const int c = lane & 7;
#pragma unroll
    for (int j = 0; j < 4; ++j) { const int n = (lane >> 3) + 8 * j; const LAS float* s = scr + (8 * c) * 33 + n;
        u32x4 o; o.x = pk2(s[0 * 33], s[1 * 33]); o.y = pk2(s[2 * 33], s[3 * 33]); o.z = pk2(s[4 * 33], s[5 * 33]); o.w = pk2(s[6 * 33], s[7 * 33]);
        *(u32x4*)(WT + (size_t)(n0d + n) * Kd + k0 + 8 * c) = o; }
    asm volatile("s_waitcnt lgkmcnt(0)" ::: "memory");
}


DI f32x16 mfma32(bf16x8 a, bf16x8 b, f32x16 c) { return __builtin_amdgcn_mfma_f32_32x32x16_bf16(a, b, c, 0, 0, 0); }
DI bf16x8 ldfrag(const bf16_t* ubase, int fidx, unsigned lo16) { return *(const bf16x8*)((const char*)(ubase + fidx * 512) + lo16); }
DI bf16x8 packstep(const f32x16& x, int s) { u32x4 p; p.x = cvt_pk_bf16(x[8 * s], x[8 * s + 1]); p.y = cvt_pk_bf16(x[8 * s + 2], x[8 * s + 3]); p.z = cvt_pk_bf16(x[8 * s + 4], x[8 * s + 5]); p.w = cvt_pk_bf16(x[8 * s + 6], x[8 * s + 7]); return __builtin_bit_cast(bf16x8, p); }
DI int crow(int i, int h) { return (i & 3) + 8 * (i >> 2) + 4 * h; }
#define SB0() __builtin_amdgcn_sched_barrier(0)
DI void stage_vec(LAS float* dst, const float* SRC, int gi, int vs, int lane) {
    const size_t cb0 = (size_t)(gi >> 4) * 256 + (gi & 15) * CPS;
#pragma unroll
    for (int k = 0; k < 4; ++k) { const int c = 4 * vs + k; *(LAS f32x2*)(dst + c * 128 + 2 * lane) = *(const f32x2*)((const char*)(SRC + (cb0 + c) * 128) + (unsigned)lane * 8u); }
}
constexpr int PA_RING = 32768, PA_STAGE = 32768;
DI void scan_pass_a(int gi, int vs, int lane, LAS unsigned char* lds, LAS float* decl, const bf16_t* KBT, const bf16_t* VT, const float* DEC, float* SLOC, float* DSEG) {
    const int h = lane >> 5, bh = gi >> 4, g = gi & 15, grp = (int)((decl - (LAS float*)(lds + 4096)) >> 11);
    const unsigned lo16 = (unsigned)lane * 16u;
    f32x16 S[4];
#pragma unroll
    for (int kt = 0; kt < 4; ++kt)
#pragma unroll
        for (int i = 0; i < 16; ++i) S[kt][i] = 0.f;
    const size_t cb0 = (size_t)bh * 256 + g * CPS;
    LAS unsigned char* ring = lds + PA_RING + grp * 16384;
#define PA_ISSUE(c_) do { const int cc_ = (c_) < CPS ? (c_) : CPS - 1; LAS unsigned char* st_ = ring + ((c_) & 3) * PA_STAGE; \
        const char* kb_ = (const char*)(KBT + (cb0 + cc_) * 4096 + (2 * vs) * 512); const char* vb_ = (const char*)(VT + (cb0 + cc_) * 4096 + (2 * vs) * 512); \
        __builtin_amdgcn_global_load_lds((const unsigned*)(kb_ + lo16), (LAS unsigned*)(st_ + (2 * vs) * 1024), 16, 0, 0); \
        __builtin_amdgcn_global_load_lds((const unsigned*)(kb_ + 1024 + lo16), (LAS unsigned*)(st_ + (2 * vs + 1) * 1024), 16, 0, 0); \
        __builtin_amdgcn_global_load_lds((const unsigned*)(vb_ + lo16), (LAS unsigned*)(st_ + 8192 + (2 * vs) * 1024), 16, 0, 0); \
        __builtin_amdgcn_global_load_lds((const unsigned*)(vb_ + 1024 + lo16), (LAS unsigned*)(st_ + 8192 + (2 * vs + 1) * 1024), 16, 0, 0); } while (0)
    PA_ISSUE(0); PA_ISSUE(1); PA_ISSUE(2);
    for (int c = 0; c < CPS; ++c) {
        asm volatile("s_waitcnt vmcnt(8)" ::: "memory");
        __builtin_amdgcn_s_barrier();
        asm volatile("" ::: "memory");
        PA_ISSUE(c + 3);
        const LAS unsigned char* st = ring + (c & 3) * PA_STAGE;
        bf16x8 kf[8], vf[2];
#pragma unroll
        for (int f = 0; f < 8; ++f) kf[f] = *(const LAS bf16x8*)(st + f * 1024 + lo16);
        vf[0] = *(const LAS bf16x8*)(st + 8192 + (2 * vs) * 1024 + lo16); vf[1] = *(const LAS bf16x8*)(st + 8192 + (2 * vs + 1) * 1024 + lo16);
#pragma unroll
        for (int kt = 0; kt < 4; ++kt) {
            f32x4 d[4];
#pragma unroll
            for (int i4 = 0; i4 < 4; ++i4) d[i4] = *(const LAS f32x4*)(decl + c * 128 + 32 * kt + 8 * i4 + 4 * h);
#pragma unroll
            for (int i4 = 0; i4 < 4; ++i4)
#pragma unroll
                for (int e = 0; e < 4; ++e) S[kt][4 * i4 + e] *= d[i4][e];
            S[kt] = mfma32(kf[kt * 2], vf[0], S[kt]);
            S[kt] = mfma32(kf[kt * 2 + 1], vf[1], S[kt]); }
    }
    asm volatile("s_waitcnt vmcnt(0)" ::: "memory");
#undef PA_ISSUE
    float* sl = SLOC + (size_t)(gi * 4 + vs) * 4096;
#pragma unroll
    for (int kt = 0; kt < 4; ++kt)
#pragma unroll
        for (int i4 = 0; i4 < 4; ++i4) *(f32x4*)((char*)(sl + (kt * 4 + i4) * 256) + lo16) = (f32x4){S[kt][4 * i4], S[kt][4 * i4 + 1], S[kt][4 * i4 + 2], S[kt][4 * i4 + 3]};
    if (vs == 0) {
        f32x2 p = (f32x2){1.f, 1.f};
#pragma unroll 4
        for (int c = 0; c < CPS; ++c) p = p * *(const f32x2*)((const char*)(DEC + (cb0 + c) * 128) + (lo16 >> 1));
        *(f32x2*)((char*)(DSEG + (size_t)gi * 128) + (lo16 >> 1)) = p; }
}
DI void scan_pass_b(int gi, int vs, int wave, int lane, LAS float* xl, LAS float* decl, const bf16_t* KA, const bf16_t* QA, const bf16_t* KBT, const bf16_t* VT, const float* DEC,
                    const float* SLOC, const float* DSEG, const bf16_t* GF, const float* og, bf16_t* OA) {
    const int r = lane & 31, h = lane >> 5, bh = gi >> 4, g = gi & 15, b = bh >> 2, hh = bh & 3, grp = wave >> 2;
    const unsigned lo16 = (unsigned)lane * 16u, ho16 = (unsigned)h * 16u;
    f32x16 S[4];
#pragma unroll
    for (int kt = 0; kt < 4; ++kt)
#pragma unroll
        for (int i = 0; i < 16; ++i) S[kt][i] = 0.f;
    if (g > 0) {
        f32x4 P[4][4];
#pragma unroll
        for (int kt = 0; kt < 4; ++kt)
#pragma unroll
            for (int i4 = 0; i4 < 4; ++i4) P[kt][i4] = (f32x4){1.f, 1.f, 1.f, 1.f};
        for (int j = g - 1; j >= 0; --j) {
            const float* sl = SLOC + (size_t)((gi - g + j) * 4 + vs) * 4096; const float* ds = DSEG + (size_t)(gi - g + j) * 128;
            float pmx = 0.f;
#pragma unroll
            for (int kt = 0; kt < 4; ++kt) {
#pragma unroll
                for (int i4 = 0; i4 < 4; ++i4) { const f32x4 x = *(const f32x4*)((const char*)(sl + (kt * 4 + i4) * 256) + lo16); const f32x4 d = *(const f32x4*)((const char*)(ds + 32 * kt + 8 * i4) + ho16);
#pragma unroll
                    for (int e = 0; e < 4; ++e) { S[kt][4 * i4 + e] += P[kt][i4][e] * x[e]; P[kt][i4][e] *= d[e]; pmx = fmaxf(pmx, P[kt][i4][e]); } }
                SB0(); }
            if (__all(pmx == 0.f)) break;
        }
    }
    const float ogv = og[vs * 32 + r];
    const size_t cb0 = (size_t)bh * 256 + g * CPS;
    bf16x8 ka[8], qa[8], kb[8], v0, v1; u32x2 gq[4];
#pragma unroll
    for (int ks = 0; ks < 8; ++ks) { ka[ks] = ldfrag(KA + cb0 * 4096, ks, lo16); qa[ks] = ldfrag(QA + cb0 * 4096, ks, lo16); kb[ks] = ldfrag(KBT + cb0 * 4096, ks, lo16); }
    v0 = ldfrag(VT + cb0 * 4096, vs * 2, lo16); v1 = ldfrag(VT + cb0 * 4096, vs * 2 + 1, lo16);
#pragma unroll
    for (int i4 = 0; i4 < 4; ++i4) gq[i4] = *(const u32x2*)((const char*)(GF + cb0 * 4096 + vs * 1024 + i4 * 256) + (lo16 >> 1));
    for (int c = 0; c < CPS; ++c) {
        const size_t cn = cb0 + (c + 1 < CPS ? c + 1 : c);
        SB0();
        f32x16 X;
#pragma unroll
        for (int i = 0; i < 16; ++i) X[i] = 0.f;
#pragma unroll
        for (int ks = 0; ks < 8; ++ks) X = mfma32(ka[ks], qa[ks], X);
#pragma unroll
        for (int i = 0; i < 16; ++i) if (crow(i, h) > r) X[i] = 0.f;
        const bf16x8 px0 = packstep(X, 0), px1 = packstep(X, 1);
        SB0();
#pragma unroll
        for (int ks = 0; ks < 8; ++ks) ka[ks] = ldfrag(KA + cn * 4096, ks, lo16);
        SB0();
        f32x16 O;
#pragma unroll
        for (int i = 0; i < 16; ++i) O[i] = 0.f;
        O = mfma32(px0, v0, O); O = mfma32(px1, v1, O);
#pragma unroll
        for (int kt = 0; kt < 4; ++kt) {
            f32x16 Se;
#pragma unroll
            for (int i4 = 0; i4 < 4; ++i4) { const f32x4 er = *(const LAS f32x4*)(decl + 4096 + c * 128 + 32 * kt + 8 * i4 + 4 * h);
#pragma unroll
                for (int e = 0; e < 4; ++e) Se[4 * i4 + e] = S[kt][4 * i4 + e] * er[e]; }
            O = mfma32(qa[kt * 2], packstep(Se, 0), O); O = mfma32(qa[kt * 2 + 1], packstep(Se, 1), O); }
        SB0();
#pragma unroll
        for (int ks = 0; ks < 8; ++ks) qa[ks] = ldfrag(QA + cn * 4096, ks, lo16);
        SB0();
#pragma unroll
        for (int kt = 0; kt < 4; ++kt) {
            f32x4 d[4];
#pragma unroll
            for (int i4 = 0; i4 < 4; ++i4) d[i4] = *(const LAS f32x4*)(decl + c * 128 + 32 * kt + 8 * i4 + 4 * h);
#pragma unroll
            for (int i4 = 0; i4 < 4; ++i4)
#pragma unroll
                for (int e = 0; e < 4; ++e) S[kt][4 * i4 + e] *= d[i4][e];
            S[kt] = mfma32(kb[kt * 2], v0, S[kt]); S[kt] = mfma32(kb[kt * 2 + 1], v1, S[kt]); }
        SB0();
#pragma unroll
        for (int ks = 0; ks < 8; ++ks) kb[ks] = ldfrag(KBT + cn * 4096, ks, lo16);
        v0 = ldfrag(VT + cn * 4096, vs * 2, lo16); v1 = ldfrag(VT + cn * 4096, vs * 2 + 1, lo16);
        SB0();
        float ss[16];
        LAS float* xb = xl + (c & 1) * 256;
        {
#pragma unroll
        for (int i = 0; i < 16; ++i) ss[i] = O[i] * O[i];
        {   const bool b0 = lane & 1, b1 = lane & 2, b2 = lane & 4, b3 = lane & 8;
            float a8[8], a4[4], a2[2];
#pragma unroll
            for (int j = 0; j < 8; ++j) { const float keep = b0 ? ss[2 * j + 1] : ss[2 * j], send = b0 ? ss[2 * j] : ss[2 * j + 1]; a8[j] = keep + dppf<0xB1>(send); }
#pragma unroll
            for (int j = 0; j < 4; ++j) { const float keep = b1 ? a8[2 * j + 1] : a8[2 * j], send = b1 ? a8[2 * j] : a8[2 * j + 1]; a4[j] = keep + dppf<0x4E>(send); }
#pragma unroll
            for (int j = 0; j < 2; ++j) { const float keep = b2 ? a4[2 * j + 1] : a4[2 * j], send = b2 ? a4[2 * j] : a4[2 * j + 1];
                const int si = __builtin_bit_cast(int, send);
                const int t0 = __builtin_amdgcn_update_dpp(si, si, 0x104, 0xf, 0x5, false);
                const int t1 = __builtin_amdgcn_update_dpp(t0, si, 0x114, 0xf, 0xa, false);
                a2[j] = keep + __builtin_bit_cast(float, t1); }
            const float keep = b3 ? a2[1] : a2[0], send = b3 ? a2[0] : a2[1];
            ss[0] = xor16_sum(keep + dppf<0x128>(send));
        }
        if (r < 16) xb[wave * 32 + 8 * (r >> 2) + 4 * h + (r & 3)] = ss[0];
        asm volatile("s_waitcnt lgkmcnt(0)" ::: "memory"); __builtin_amdgcn_s_barrier(); asm volatile("" ::: "memory");
        }
        bf16_t* orow = OA + ((size_t)b * SEQ + g * (CPS * 32) + c * 32) * HGW + hh * 128 + vs * 32;
        const unsigned oo = (unsigned)(4 * h * HGW + r) * 2u;
#pragma unroll
        for (int i4 = 0; i4 < 4; ++i4) {
            f32x4 tot = *(const LAS f32x4*)(xb + (grp * 4 + 0) * 32 + 8 * i4 + 4 * h);
#pragma unroll
            for (int s = 1; s < 4; ++s) tot = tot + *(const LAS f32x4*)(xb + (grp * 4 + s) * 32 + 8 * i4 + 4 * h);
            const float gv[4] = {bflo(gq[i4].x), bfhi(gq[i4].x), bflo(gq[i4].y), bfhi(gq[i4].y)};
#pragma unroll
            for (int e2 = 0; e2 < 2; ++e2) { const int i = 4 * i4 + 2 * e2;
                const float sc0 = __builtin_amdgcn_rsqf(tot[2 * e2] * (1.0f / 128.0f) + EPS) * ogv, sc1 = __builtin_amdgcn_rsqf(tot[2 * e2 + 1] * (1.0f / 128.0f) + EPS) * ogv;
                const unsigned w = cvt_pk_bf16(O[i] * sc0 * gv[2 * e2], O[i + 1] * sc1 * gv[2 * e2 + 1]);
                *(bf16_t*)((char*)(orow + ((i & 3) + 8 * (i >> 2)) * HGW) + oo) = (bf16_t)(w & 0xffffu);
                *(bf16_t*)((char*)(orow + (((i + 1) & 3) + 8 * ((i + 1) >> 2)) * HGW) + oo) = (bf16_t)(w >> 16); } }
#pragma unroll
        for (int i4 = 0; i4 < 4; ++i4) gq[i4] = *(const u32x2*)((const char*)(GF + cn * 4096 + vs * 1024 + i4 * 256) + (lo16 >> 1));
    }
}

DI void attn_task(int b, int kvh, int gq, int qt, int lane, const bf16_t* AQ, const LAS unsigned char* kst, const bf16_t* AVT, const float* sinks, bf16_t* OB) {
    const int head = kvh * 4 + gq, r = lane & 31, h = lane >> 5;
    const unsigned lo16 = (unsigned)lane * 16u;
    const bf16_t* qblk = AQ + ((size_t)(b * 8 + head) * 256 + qt) * 2048;
    const bf16_t* vbase = AVT + (size_t)(b * 2 + kvh) * 256 * 2048;
    bf16x8 qf[4], kv[5][4];
#pragma unroll
    for (int ks = 0; ks < 4; ++ks) qf[ks] = ldfrag(qblk, ks, lo16);
#pragma unroll
    for (int kt = 0; kt < 5; ++kt)
#pragma unroll
        for (int ks = 0; ks < 4; ++ks) kv[kt][ks] = *(const LAS bf16x8*)(kst + (kt * 4 + ks) * 1024 + lo16);
    const float slope2 = __builtin_amdgcn_exp2f(-(float)(head + 1)) * LOG2E, sink2 = sinks[head] * LOG2E;
    f32x16 X[5];
    float mx = sink2;
    const int rbi = r - 4 * h; float rb = (float)rbi; asm volatile("" : "+v"(rb));
    SB0();
#pragma unroll
    for (int kt = 0; kt < 5; ++kt) {
        f32x16 x;
#pragma unroll
        for (int i = 0; i < 16; ++i) x[i] = 0.f;
#pragma unroll
        for (int ks = 0; ks < 4; ++ks) x = mfma32(kv[kt][ks], qf[ks], x);
        const bool tile_ok = qt - 4 + kt >= 0;
#pragma unroll
        for (int i = 0; i < 16; ++i) { const int ci = (i & 3) + 8 * (i >> 2);
            float v = x[i] - slope2 * (rb + (float)(128 - 32 * kt - ci));
            if (kt == 0 && !(ci > rbi)) v = -1e30f;
            if (kt == 4 && !(ci <= rbi)) v = -1e30f;
            if (!tile_ok) v = -1e30f;
            x[i] = v; mx = fmaxf(mx, v); }
        X[kt] = x;
    }
    SB0();
#pragma unroll
    for (int kt = 0; kt < 5; ++kt) { const int vn = qt - 4 + kt < 0 ? 0 : qt - 4 + kt;
#pragma unroll
        for (int f = 0; f < 4; ++f) kv[kt][f] = ldfrag(vbase + vn * 2048, f, lo16); }
    SB0();
    mx = xor32_max(mx);
    float l = 0.f;
#pragma unroll
    for (int kt = 0; kt < 5; ++kt)
#pragma unroll
        for (int i = 0; i < 16; ++i) { const float p = __builtin_amdgcn_exp2f(X[kt][i] - mx); X[kt][i] = p; l += p; }
    l = xor32_sum(l);
    l += __builtin_amdgcn_exp2f(sink2 - mx);
    f32x16 O[2];
#pragma unroll
    for (int dt = 0; dt < 2; ++dt)
#pragma unroll
        for (int i = 0; i < 16; ++i) O[dt][i] = 0.f;
    SB0();
#pragma unroll
    for (int kt = 0; kt < 5; ++kt) {
#pragma unroll
        for (int ks = 0; ks < 2; ++ks) { const bf16x8 pf = packstep(X[kt], ks);
#pragma unroll
            for (int dt = 0; dt < 2; ++dt) O[dt] = mfma32(pf, kv[kt][dt * 2 + ks], O[dt]); }
    }
    SB0();
    const float linv = __builtin_amdgcn_rcpf(l);
    bf16_t* orow = OB + ((size_t)b * SEQ + qt * 32) * ATW + head * 64;
    const unsigned oo = (unsigned)(4 * h * ATW + r) * 2u;
#pragma unroll
    for (int i = 0; i < 16; ++i) { const int t = crow(i, h); const float li = __shfl(linv, t);
        { const unsigned w = cvt_pk_bf16(O[0][i] * li, O[1][i] * li);
          *(bf16_t*)((char*)(orow + ((i & 3) + 8 * (i >> 2)) * ATW) + oo) = (bf16_t)(w & 0xffffu); *(bf16_t*)((char*)(orow + ((i & 3) + 8 * (i >> 2)) * ATW + 32) + oo) = (bf16_t)(w >> 16); } }
}

#define XB_TMO      128
#define XB_XCNT(j)  (256  + 64 * (j))
#define XB_XSUB(j)  (1280 + 64 * (j))
#define XB_XGEN(j)  (2304 + 64 * (j))
#define XB_TOP      3328
#define XB_TOPGEN   3392
#define XCD_BAR_WORDS 3456
#define XB_SPIN_CAP (1u << 18)
DI unsigned xb_ld(unsigned* p)              { return __hip_atomic_load(p, __ATOMIC_RELAXED, __HIP_MEMORY_SCOPE_AGENT); }
DI unsigned xb_add(unsigned* p, unsigned v) { return __hip_atomic_fetch_add(p, v, __ATOMIC_RELAXED, __HIP_MEMORY_SCOPE_AGENT); }
DI unsigned xb_xcc_id() { return (unsigned)__builtin_amdgcn_s_getreg((3 << 11) | 20) & 0xFu; }
#define XB_SPIN(cond, bar) do { unsigned _sp = 0; while (cond) { __builtin_amdgcn_s_sleep(1); \
    if ((++_sp & 255u) == 0u) { if (xb_ld(&(bar)[XB_TMO])) break; if (_sp > XB_SPIN_CAP) { atomicAdd(&(bar)[XB_TMO], 1u); break; } } } } while (0)
struct XcdBarrier { unsigned* bar; unsigned x; };
DI XcdBarrier xcd_barrier_post(unsigned* bar) {
    XcdBarrier b; b.bar = bar; b.x = xb_xcc_id();
    if (threadIdx.x == 0) (void)xb_add(&bar[XB_XCNT(b.x)], 1u);
    return b;
}
DI void xcd_barrier_complete(unsigned* bar, unsigned x, unsigned& nloc, unsigned& nx) {
    const unsigned G = gridDim.x * gridDim.y * gridDim.z;
    unsigned sum, cnt, mine, sp = 0u;
    for (;;) {
        sum = 0u; cnt = 0u; mine = 0u;
#pragma unroll
        for (unsigned j = 0; j < 16; ++j) { const unsigned c = xb_ld(&bar[XB_XCNT(j)]); sum += c; cnt += (c > 0u) ? 1u : 0u; mine = (j == x) ? c : mine; }
        if (sum == G) break;
        __builtin_amdgcn_s_sleep(1);
        if ((++sp & 255u) == 0u) { if (xb_ld(&bar[XB_TMO])) break; if (sp > XB_SPIN_CAP) { atomicAdd(&bar[XB_TMO], 1u); break; } }
    }
    nloc = mine > 0u ? mine : 1u; nx = cnt > 0u ? cnt : 1u;
}
DI void xcd_barrier(const XcdBarrier& b, const bool leader, unsigned& nloc, unsigned& nx) {
    asm volatile("s_waitcnt vmcnt(0)" ::: "memory");
    __syncthreads();
    if (leader) {
        unsigned* bar = b.bar;
        __builtin_amdgcn_s_waitcnt(0);
        if (nloc == 0u) xcd_barrier_complete(bar, b.x, nloc, nx);
        const unsigned old = xb_add(&bar[XB_XSUB(b.x)], 1u);
        const unsigned gen = old / nloc;
        if (old + 1u == (gen + 1u) * nloc) {
            __builtin_amdgcn_fence(__ATOMIC_RELEASE, "agent");
            asm volatile("s_waitcnt vmcnt(0)" ::: "memory");
            const unsigned og = xb_add(&bar[XB_TOP], 1u);
            const unsigned tg = og / nx;
            if (og + 1u == (tg + 1u) * nx) xb_add(&bar[XB_TOPGEN], 1u);
            else XB_SPIN(xb_ld(&bar[XB_TOPGEN]) == tg, bar);
            __builtin_amdgcn_fence(__ATOMIC_ACQUIRE, "agent");
            xb_add(&bar[XB_XGEN(b.x)], 1u);
            asm volatile("s_waitcnt vmcnt(0)" ::: "memory");
        } else {
            XB_SPIN(xb_ld(&bar[XB_XGEN(b.x)]) == gen, bar);
            __builtin_amdgcn_fence(__ATOMIC_ACQUIRE, "agent");
            asm volatile("s_waitcnt vmcnt(0)" ::: "memory");
        }
    }
    __syncthreads();
}

struct Args { const float* in[16]; float* out; unsigned char* ws; int ph_lo, ph_hi; };
constexpr int N_PHASES = 8;

__global__ void __launch_bounds__(NTHREADS, 2) fwd(Args args) {
    extern __shared__ __attribute__((aligned(16))) unsigned char lds_raw[];
    LAS unsigned char* lds = (LAS unsigned char*)lds_raw;
    const int wave = __builtin_amdgcn_readfirstlane(threadIdx.x >> 6);
    const int G = gridDim.x, bx = blockIdx.x;
    const int gw = bx * 8 + wave, NGW = G * 8;
    unsigned char* const ws = args.ws;
#define WSP(T, off) ((T*)(ws + (off)))

    const int lo = args.ph_lo, hi = args.ph_hi;
#define IN(k) (lo <= (k) && (k) < hi)
#define SEAM(k) do { if (IN(k) && IN((k) + 1)) { xcd_barrier(xbar, wave == 0 && lane_id() == 0, xb_nloc, xb_nx); xb_nloc = __builtin_amdgcn_readfirstlane(xb_nloc); xb_nx = __builtin_amdgcn_readfirstlane(xb_nx); } } while (0)
    unsigned xb_nloc = 0u, xb_nx = 0u;
    const XcdBarrier xbar = xcd_barrier_post((unsigned*)ws);

    if (IN(0)) {
        const int lane = lane_id(), tid = wave * 64 + lane;
        const float* x = args.in[0];
        bf16_t* WIN = WSP(bf16_t, WS_WIN); bf16_t* WA = WSP(bf16_t, WS_WA); bf16_t* WB = WSP(bf16_t, WS_WB); bf16_t* WOUT = WSP(bf16_t, WS_WOUT); bf16_t* WUP = WSP(bf16_t, WS_WUP); bf16_t* WDOWN = WSP(bf16_t, WS_WDOWN);
        bf16_t* XB = WSP(bf16_t, WS_XB); float* RMS1 = WSP(float, WS_RSTD1); float* SUMSQ2 = WSP(float, WS_SUMSQ2); float* LB = WSP(float, WS_LB);
        LAS float* scr = (LAS float*)(lds + wave * 16384);
        constexpr int I_IN = 16 * 152, I_A = 8 * 32, I_B = 8 * 32, I_OUT = 16 * 32, I_UP = 16 * 176, I_DN = 44 * 32;
        constexpr int NITEMS = I_IN + I_A + I_B + I_OUT + I_UP + I_DN;
        for (int pass = 0; pass < 2; ++pass) {
        if (((pass ^ wave) & 1) == 0) {
        for (int it = gw; it < NITEMS; it += NGW) {
            int r = it;
            if (r < I_IN) { const int kb = r / 152, nb = r % 152; transpose_item(args.in[2], DM, INC, colmap_in(32 * nb), WIN, 32 * nb, 64 * kb, args.in[1], scr, lane, in_colscale(32 * nb)); continue; } r -= I_IN;
            if (r < I_A) { const int kb = r / 32, nb = r % 32; transpose_item(args.in[8], 512, DM, 32 * nb, WA, 32 * nb, 64 * kb, nullptr, scr, lane); continue; } r -= I_A;
            if (r < I_B) { const int kb = r / 32, nb = r % 32; transpose_item(args.in[9], 512, DM, 32 * nb, WB, 32 * nb, 64 * kb, nullptr, scr, lane); continue; } r -= I_B;
            if (r < I_OUT) { const int kb = r / 32, nb = r % 32; transpose_item(args.in[10], DM, DM, 32 * nb, WOUT, 32 * nb, 64 * kb, nullptr, scr, lane); continue; } r -= I_OUT;
            if (r < I_UP) { const int kb = r / 176, nb = r % 176; transpose_item(args.in[12], DM, 2 * DFF, colmap_up(32 * nb), WUP, 32 * nb, 64 * kb, args.in[11], scr, lane); continue; } r -= I_UP;
            { const int kb = r / 32, nb = r % 32; transpose_item(args.in[15], DFF, DM, 32 * nb, WDOWN, 32 * nb, 64 * kb, nullptr, scr, lane); }
        }
        } else {
        for (int m0 = gw * 4; m0 < MTOK; m0 += NGW * 4) {
            f32x4 v[4][4]; float s[4];
#pragma unroll
            for (int q = 0; q < 4; ++q) { const f32x4* xr = (const f32x4*)(x + (size_t)(m0 + q) * DM) + lane;
#pragma unroll
                for (int j = 0; j < 4; ++j) v[q][j] = xr[64 * j]; }
#pragma unroll
            for (int q = 0; q < 4; ++q) { float a = 0.f;
#pragma unroll
                for (int j = 0; j < 4; ++j) a += (v[q][j].x * v[q][j].x + v[q][j].y * v[q][j].y) + (v[q][j].z * v[q][j].z + v[q][j].w * v[q][j].w);
                s[q] = a; }
#pragma unroll
            for (int o = 1; o < 64; o <<= 1)
#pragma unroll
                for (int q = 0; q < 4; ++q) s[q] += __shfl_xor(s[q], o);
#pragma unroll
            for (int q = 0; q < 4; ++q) { u32x2* o8 = (u32x2*)(XB + (size_t)(m0 + q) * DM) + lane; const float rs = __builtin_amdgcn_rsqf(s[q] * (1.0f / DM) + EPS);
#pragma unroll
                for (int j = 0; j < 4; ++j) { u32x2 w; w.x = cvt_pk_bf16(v[q][j].x * rs, v[q][j].y * rs); w.y = cvt_pk_bf16(v[q][j].z * rs, v[q][j].w * rs); o8[64 * j] = w; } }
            if (lane < 4) { const float sq = lane == 0 ? s[0] : lane == 1 ? s[1] : lane == 2 ? s[2] : s[3]; RMS1[m0 + lane] = __builtin_sqrtf(sq * (1.0f / DM) + EPS); SUMSQ2[m0 + lane] = 0.f; }
        }
        }
        }
        if (bx == 0) { const float l0 = args.in[3][tid], l1 = args.in[3][512 + tid]; LB[tid] = 1.0f / (1.0f + expf(l1 - l0)); }
    }
    SEAM(0);

    if (IN(1)) {
        SchedPlain S; S.T.init(MTOK / 256, INC / 256, G, bx); S.A = (const char*)(ws + WS_XB); S.Bt = (const char*)(ws + WS_WIN); S.atile = (size_t)256 * DM * 2; S.btile = (size_t)256 * DM * 2;
        EpiIn E{args.in[5], args.in[6], ws, lds, wave};
        pg8::gemm_phase<EpiIn, SchedPlain, 1>(lds, wave, DM, S, E);
    }
    SEAM(1);

    const int gi = bx * 2 + (wave >> 2), vs = wave & 3;
    if (IN(2)) {
        const int lane = lane_id();
        for (int slot = gw >> 2; slot < NB * 2 * 32; slot += NGW >> 2) {
            const int qg = slot & 31, kvh = (slot >> 5) & 1, b = slot >> 6;
            LAS unsigned char* kgrp = lds + (wave >> 2) * 49152;
            { const bf16_t* kbase = WSP(bf16_t, WS_AK) + (size_t)(b * 2 + kvh) * 256 * 2048;
#pragma unroll
              for (int k = 0; k < 12; ++k) { const int pce = (wave & 3) * 12 + k, tl = qg * 8 - 4 + (pce >> 2), kn = tl < 0 ? 0 : tl;
                  __builtin_amdgcn_global_load_lds((const unsigned*)((const char*)(kbase + (size_t)kn * 2048 + (pce & 3) * 512) + (unsigned)lane * 16u), (LAS unsigned*)(kgrp + pce * 1024), 16, 0, 0); }
              asm volatile("s_waitcnt vmcnt(0)" ::: "memory"); __syncthreads(); }
            for (int it = 0; it < 8; ++it) attn_task(b, kvh, wave & 3, qg * 8 + it, lane, WSP(bf16_t, WS_AQ), kgrp + it * 4096, WSP(bf16_t, WS_AV), args.in[7], WSP(bf16_t, WS_OB));
            __syncthreads();
        }
        LAS float* decl = (LAS float*)(lds + 4096) + (wave >> 2) * 2048;
        stage_vec(decl, WSP(float, WS_DEC), gi, vs, lane);
        __syncthreads();
        scan_pass_a(gi, vs, lane, lds, decl, WSP(bf16_t, WS_KBT), WSP(bf16_t, WS_VT), WSP(float, WS_DEC), WSP(float, WS_SLOC), WSP(float, WS_DSEG));
    }
    SEAM(2);

    if (IN(3)) {
        { LAS float* decl = (LAS float*)(lds + 4096) + (wave >> 2) * 2048; const int l_ = lane_id(); stage_vec(decl, WSP(float, WS_DEC), gi, vs, l_); stage_vec(decl + 4096, WSP(float, WS_EREF), gi, vs, l_); __syncthreads(); }
        scan_pass_b(gi, vs, wave, lane_id(), (LAS float*)lds, (LAS float*)(lds + 4096) + (wave >> 2) * 2048, WSP(bf16_t, WS_KA), WSP(bf16_t, WS_QA), WSP(bf16_t, WS_KBT), WSP(bf16_t, WS_VT), WSP(float, WS_DEC),
                    WSP(float, WS_SLOC), WSP(float, WS_DSEG), WSP(bf16_t, WS_G), args.in[4], WSP(bf16_t, WS_OA));
    }
    SEAM(3);

    if (IN(4)) {
        SchedPair S; S.T.init(MTOK / 256, DM / 256, G, bx); S.A0 = (const char*)(ws + WS_OA); S.A1 = (const char*)(ws + WS_OB); S.B0 = (const char*)(ws + WS_WA); S.B1 = (const char*)(ws + WS_WB); S.atile = (size_t)256 * 512 * 2; S.btile = (size_t)256 * 512 * 2;
        EpiBranch E{WSP(unsigned char, WS_GA), WSP(unsigned char, WS_GB), WSP(bf16_t, WS_MIXED)};
        pg8::gemm_phase<EpiBranch, SchedPair, 1>(lds, wave, 512, S, E);
    }
    SEAM(4);

    if (IN(5)) {
        SchedPlain S; S.T.init(MTOK / 256, DM / 256, G, bx); S.A = (const char*)(ws + WS_MIXED); S.Bt = (const char*)(ws + WS_WOUT); S.atile = (size_t)256 * DM * 2; S.btile = (size_t)256 * DM * 2;
        EpiOut E{WSP(bf16_t, WS_XB), WSP(float, WS_RSTD1), WSP(bf16_t, WS_X1B), WSP(float, WS_SUMSQ2)};
        pg8::gemm_phase<EpiOut, SchedPlain, 0>(lds, wave, DM, S, E);
    }
    SEAM(5);

    if (IN(6)) {
        SchedUp S; S.T.init(P4_NM, (2 * DFF) / 256, G, bx); S.A = (const char*)(ws + WS_X1B); S.Bt = (const char*)(ws + WS_WUP); S.btile = (size_t)256 * DM * 2;
        EpiUp E{WSP(float, WS_SUMSQ2), args.in[13], args.in[14], WSP(bf16_t, WS_ACT), lds};
        pg8::gemm_phase<EpiUp, SchedUp, 2>(lds, wave, DM, S, E);
    }
    SEAM(6);

    if (IN(7)) {
        SchedPlain S; S.T.init(MTOK / 256, DM / 256, G, bx); S.A = (const char*)(ws + WS_ACT); S.Bt = (const char*)(ws + WS_WDOWN); S.atile = (size_t)256 * DFF * 2; S.btile = (size_t)256 * DFF * 2;
        EpiDown E{WSP(bf16_t, WS_X1B), args.out};
        pg8::gemm_phase<EpiDown, SchedPlain, 0>(lds, wave, DFF, S, E);
    }
#undef IN
#undef SEAM
}

extern "C" void kernel_launch(void* const* d_in, const int* in_sizes, int n_in, void* d_out, int out_size, void* d_ws, size_t ws_size, hipStream_t stream) {
    static int grid = 0;
    if (grid == 0) {
        if (n_in != 16 || out_size != MTOK * DM || ws_size < WS_END) { fprintf(stderr, "kernel_launch: unexpected shapes (n_in %d out %d ws %zu)\n", n_in, out_size, ws_size); grid = -1; return; }
        int dev = 0, cus = 0, per_cu = 0;
        hipGetDevice(&dev);
        hipDeviceGetAttribute(&cus, hipDeviceAttributeMultiprocessorCount, dev);
        hipFuncSetAttribute((const void*)fwd, hipFuncAttributeMaxDynamicSharedMemorySize, LDS_BYTES);
        hipOccupancyMaxActiveBlocksPerMultiprocessor(&per_cu, (const void*)fwd, NTHREADS, LDS_BYTES);
        if (per_cu < 1) { fprintf(stderr, "kernel_launch: occupancy query says %d blocks per CU\n", per_cu); per_cu = 1; }
        (void)hipGetLastError();
        grid = cus * 1;
    }
    if (grid < 0) return;
    if (hipMemsetAsync(d_ws, 0, 65536, stream) != hipSuccess) { fprintf(stderr, "kernel_launch: memset of the barrier words failed\n"); return; }
    Args a{};
    for (int i = 0; i < 16; ++i) a.in[i] = (const float*)d_in[i];
    a.out = (float*)d_out; a.ws = (unsigned char*)d_ws;
#if MK_N_LAUNCHES == 1
    a.ph_lo = 0; a.ph_hi = N_PHASES;
    void* kargs[] = {&a};
    hipError_t e = hipLaunchCooperativeKernel((const void*)fwd, dim3(grid), dim3(NTHREADS), kargs, LDS_BYTES, stream);
    if (e != hipSuccess) fprintf(stderr, "kernel_launch: cooperative launch failed: %s (grid %d)\n", hipGetErrorString(e), grid);
#else
    for (int p = 0; p < N_PHASES; ++p) { a.ph_lo = p; a.ph_hi = p + 1; hipLaunchKernelGGL(fwd, dim3(grid), dim3(NTHREADS), LDS_BYTES, stream, a); }
#endif
}
```
